# Optimizing an MI355X kernel written in HIP

```python
import math
import jax, jax.numpy as jnp
from jax import lax
import numpy as np

D_MODEL = 1024
BATCH = 8
SEQ = 2048
DEPTH = 2

HEAD_DIM = 64
ROPE_THETA = 10000.0
NORM_EPS = 1e-6
Q_BLOCK = 128

MLA_HEADS = 6
MLA_Q_RANK = 384
MLA_KV_RANK = 256
MLA_NOPE_DIM = 64
MLA_ROPE_DIM = 32
MLA_V_DIM = 64

SWA_HEADS = 6
SWA_KV_HEADS = 2
WINDOW = 128

DIFF_HEADS = 4
DIFF_QK_DIM = 32
DIFF_V_DIM = 64

MIX_WIDTH = MLA_HEADS * MLA_V_DIM + SWA_HEADS * HEAD_DIM + DIFF_HEADS * DIFF_V_DIM

IN_SPLITS = (
    MLA_Q_RANK, MLA_KV_RANK, MLA_ROPE_DIM,
    SWA_HEADS * HEAD_DIM, SWA_KV_HEADS * HEAD_DIM, SWA_KV_HEADS * HEAD_DIM,
    DIFF_HEADS * 2 * DIFF_QK_DIM, DIFF_HEADS * 2 * DIFF_QK_DIM, DIFF_HEADS * DIFF_V_DIM,
)
IN_WIDTH = sum(IN_SPLITS)

N_GROUPS = 4
EXPERTS_PER_GROUP = 8
TOP_K = 2
EXPERT_FF = 256

kernel_name = "hymba_style_mla_swa_diff_hmoe_encoder"


def rms_norm(x, g):
    xf = x.astype(jnp.float32)
    y = xf * lax.rsqrt(jnp.mean(xf * xf, axis=-1, keepdims=True) + NORM_EPS)
    return (y * g.astype(jnp.float32)).astype(x.dtype)


def rope_tables(seq, dim):
    inv = 1.0 / (ROPE_THETA ** (jnp.arange(0, dim, 2, dtype=jnp.float32) / dim))
    ang = jnp.arange(seq, dtype=jnp.float32)[:, None] * inv[None, :]
    return jnp.cos(ang), jnp.sin(ang)


def apply_rope(x, cos, sin):
    shape = (cos.shape[0],) + (1,) * (x.ndim - 3) + (cos.shape[1],)
    c = cos.reshape(shape).astype(x.dtype)
    s = sin.reshape(shape).astype(x.dtype)
    x1, x2 = jnp.split(x, 2, axis=-1)
    return jnp.concatenate([x1 * c - x2 * s, x2 * c + x1 * s], axis=-1)


def sweep_query_blocks(fn, *qs):
    B, S = qs[0].shape[:2]
    nb = S // Q_BLOCK
    blocked = tuple(jnp.moveaxis(q.reshape((B, nb, Q_BLOCK) + q.shape[2:]), 1, 0) for q in qs)
    out = lax.map(lambda args: fn(*args), blocked)
    return jnp.moveaxis(out, 0, 1).reshape((B, S) + out.shape[3:])


def mla_mixer(c_q, c_kv, k_rope, q_norm, kv_norm, w_uq, w_ukv, rope):
    B, S, _ = c_q.shape
    q = (rms_norm(c_q, q_norm) @ w_uq).reshape(B, S, MLA_HEADS, MLA_NOPE_DIM + MLA_ROPE_DIM)
    q_nope = q[..., :MLA_NOPE_DIM]
    q_rope = apply_rope(q[..., MLA_NOPE_DIM:], *rope)
    kv = (rms_norm(c_kv, kv_norm) @ w_ukv).reshape(B, S, MLA_HEADS, MLA_NOPE_DIM + MLA_V_DIM)
    k_nope = kv[..., :MLA_NOPE_DIM]
    v = kv[..., MLA_NOPE_DIM:]
    k_rope = apply_rope(k_rope, *rope)
    scale = (MLA_NOPE_DIM + MLA_ROPE_DIM) ** -0.5

    def block(qn, qr):
        s = (jnp.einsum('bqhd,bkhd->bhqk', qn, k_nope)
             + jnp.einsum('bqhr,bkr->bhqk', qr, k_rope))
        p = jax.nn.softmax(s.astype(jnp.float32) * scale, axis=-1)
        return jnp.einsum('bhqk,bkhd->bqhd', p.astype(v.dtype), v)

    o = sweep_query_blocks(block, q_nope, q_rope)
    return o.reshape(B, S, MLA_HEADS * MLA_V_DIM)


def swa_mixer(q, k, v, sink, rope):
    B, S, _ = q.shape
    G = SWA_HEADS // SWA_KV_HEADS
    nb = S // WINDOW
    q = apply_rope(q.reshape(B, S, SWA_HEADS, HEAD_DIM), *rope)
    k = apply_rope(k.reshape(B, S, SWA_KV_HEADS, HEAD_DIM), *rope)
    v = v.reshape(B, S, SWA_KV_HEADS, HEAD_DIM)
    qb = q.reshape(B, nb, WINDOW, SWA_KV_HEADS, G, HEAD_DIM)

    def band(t):
        tp = jnp.pad(t, ((0, 0), (WINDOW, WINDOW), (0, 0), (0, 0)))
        tp = tp.reshape(B, nb + 2, WINDOW, SWA_KV_HEADS, HEAD_DIM)
        return jnp.concatenate([tp[:, :-2], tp[:, 1:-1], tp[:, 2:]], axis=2)

    kb, vb = band(k), band(v)
    s = jnp.einsum('bnqhgd,bnkhd->bnhgqk', qb, kb).astype(jnp.float32) * (HEAD_DIM ** -0.5)
    a = jnp.arange(WINDOW)[:, None]
    c = jnp.arange(3 * WINDOW)[None, :]
    rel = c - a
    in_window = (rel >= 0) & (rel <= 2 * WINDOW)
    key_pos = jnp.arange(nb)[:, None] * WINDOW - WINDOW + jnp.arange(3 * WINDOW)[None, :]
    in_range = (key_pos >= 0) & (key_pos < S)
    valid = in_window[None] & in_range[:, None, :]
    s = jnp.where(valid[None, :, None, None], s, -jnp.inf)
    sink_logit = jnp.broadcast_to(
        sink.astype(jnp.float32).reshape(1, 1, SWA_KV_HEADS, G, 1, 1), s.shape[:-1] + (1,))
    p = jax.nn.softmax(jnp.concatenate([s, sink_logit], axis=-1), axis=-1)[..., :-1]
    o = jnp.einsum('bnhgqk,bnkhd->bnqhgd', p.astype(vb.dtype), vb)
    return o.reshape(B, S, SWA_HEADS * HEAD_DIM)


def diff_mixer(q, k, v, lq1, lk1, lq2, lk2, subln, lambda_init, rope):
    B, S, _ = q.shape
    q = apply_rope(q.reshape(B, S, DIFF_HEADS, 2, DIFF_QK_DIM), *rope)
    k = apply_rope(k.reshape(B, S, DIFF_HEADS, 2, DIFF_QK_DIM), *rope)
    v = v.reshape(B, S, DIFF_HEADS, DIFF_V_DIM)
    lam = (jnp.exp(jnp.sum(lq1.astype(jnp.float32) * lk1.astype(jnp.float32)))
           - jnp.exp(jnp.sum(lq2.astype(jnp.float32) * lk2.astype(jnp.float32)))
           + lambda_init)
    scale = DIFF_QK_DIM ** -0.5

    def block(qb):
        s = jnp.einsum('bqhcd,bkhcd->bhcqk', qb, k)
        p = jax.nn.softmax(s.astype(jnp.float32) * scale, axis=-1)
        attn = p[:, :, 0] - lam * p[:, :, 1]
        return jnp.einsum('bhqk,bkhd->bqhd', attn.astype(v.dtype), v)

    o = sweep_query_blocks(block, q)
    o = rms_norm(o, subln) * (1.0 - lambda_init)
    return o.reshape(B, S, DIFF_HEADS * DIFF_V_DIM)


def hier_moe(h, w_rg, b_rg, w_re, b_re, w_gate, w_up, w_down):
    B, S, D = h.shape
    t = h.reshape(B * S, D)
    T = t.shape[0]
    g_logits = (t @ w_rg).astype(jnp.float32) + b_rg.astype(jnp.float32)
    g_prob = jax.nn.softmax(g_logits, axis=-1)
    g_idx = jnp.argmax(g_logits, axis=-1)
    g_gate = jnp.take_along_axis(g_prob, g_idx[:, None], axis=-1)
    e_logits = ((t @ w_re).astype(jnp.float32) + b_re.astype(jnp.float32)).reshape(
        T, N_GROUPS, EXPERTS_PER_GROUP)
    e_in = jnp.take_along_axis(e_logits, g_idx[:, None, None], axis=1)[:, 0]
    top_val, top_idx = lax.top_k(e_in, TOP_K)
    top_w = jax.nn.softmax(top_val, axis=-1) * g_gate
    comb_e = jnp.sum(jax.nn.one_hot(top_idx, EXPERTS_PER_GROUP) * top_w[..., None], axis=1)
    comb = (jax.nn.one_hot(g_idx, N_GROUPS)[:, :, None] * comb_e[:, None, :]).astype(t.dtype)
    y = jnp.zeros_like(t)
    for g in range(N_GROUPS):
        a = jnp.einsum('td,edf->tef', t, w_gate[g])
        u = jnp.einsum('td,edf->tef', t, w_up[g])
        hid = jax.nn.silu(a) * u * comb[:, g, :, None]
        y = y + jnp.einsum('tef,efd->td', hid, w_down[g])
    return y.reshape(B, S, D)


def _split_points():
    pts, acc = [], 0
    for w in IN_SPLITS[:-1]:
        acc += w
        pts.append(acc)
    return pts


def setup_inputs(seed: int = 0) -> dict:
    key = jax.random.key(seed)
    ks = jax.random.split(key, 32)

    def nrm(k, shape, scale):
        return jax.random.normal(k, shape, jnp.float32) * scale

    def gain(k, shape):
        return 1.0 + 0.02 * jax.random.normal(k, shape, jnp.float32)

    L, D, E, G, F = DEPTH, D_MODEL, EXPERTS_PER_GROUP, N_GROUPS, EXPERT_FF
    return {
        "x": nrm(ks[0], (BATCH, SEQ, D), 1.0),
        "attn_norm": gain(ks[1], (L, D)),
        "w_in": nrm(ks[2], (L, D, IN_WIDTH), D ** -0.5),
        "mla_q_norm": gain(ks[3], (L, MLA_Q_RANK)),
        "mla_kv_norm": gain(ks[4], (L, MLA_KV_RANK)),
        "mla_w_uq": nrm(ks[5], (L, MLA_Q_RANK, MLA_HEADS * (MLA_NOPE_DIM + MLA_ROPE_DIM)), MLA_Q_RANK ** -0.5),
        "mla_w_ukv": nrm(ks[6], (L, MLA_KV_RANK, MLA_HEADS * (MLA_NOPE_DIM + MLA_V_DIM)), MLA_KV_RANK ** -0.5),
        "swa_sink": nrm(ks[7], (L, SWA_HEADS), 0.5),
        "diff_lq1": nrm(ks[8], (L, DIFF_QK_DIM), 0.1),
        "diff_lk1": nrm(ks[9], (L, DIFF_QK_DIM), 0.1),
        "diff_lq2": nrm(ks[10], (L, DIFF_QK_DIM), 0.1),
        "diff_lk2": nrm(ks[11], (L, DIFF_QK_DIM), 0.1),
        "diff_subln": gain(ks[12], (L, DIFF_V_DIM)),
        "w_out": nrm(ks[13], (L, MIX_WIDTH, D), MIX_WIDTH ** -0.5),
        "ffn_norm": gain(ks[14], (L, D)),
        "router_group": nrm(ks[15], (L, D, G), D ** -0.5),
        "router_group_bias": nrm(ks[16], (L, G), 0.01),
        "router_expert": nrm(ks[17], (L, D, G * E), D ** -0.5),
        "router_expert_bias": nrm(ks[18], (L, G * E), 0.01),
        "w_gate": nrm(ks[19], (L, G, E, D, F), D ** -0.5),
        "w_up": nrm(ks[20], (L, G, E, D, F), D ** -0.5),
        "w_down": nrm(ks[21], (L, G, E, F, D), F ** -0.5),
        "final_norm": gain(ks[22], (D,)),
    }


def reference(x, attn_norm, w_in, mla_q_norm, mla_kv_norm, mla_w_uq, mla_w_ukv, swa_sink,
              diff_lq1, diff_lk1, diff_lq2, diff_lk2, diff_subln, w_out, ffn_norm,
              router_group, router_group_bias, router_expert, router_expert_bias,
              w_gate, w_up, w_down, final_norm):
    S = x.shape[1]
    rope32 = rope_tables(S, MLA_ROPE_DIM)
    rope64 = rope_tables(S, HEAD_DIM)
    points = _split_points()
    for l in range(DEPTH):
        h = rms_norm(x, attn_norm[l])
        (mq, mkv, mkr, sq, sk, sv, dq, dk, dv) = jnp.split(h @ w_in[l], points, axis=-1)
        o_mla = mla_mixer(mq, mkv, mkr, mla_q_norm[l], mla_kv_norm[l], mla_w_uq[l], mla_w_ukv[l], rope32)
        o_swa = swa_mixer(sq, sk, sv, swa_sink[l], rope64)
        lambda_init = 0.8 - 0.6 * math.exp(-0.3 * l)
        o_diff = diff_mixer(dq, dk, dv, diff_lq1[l], diff_lk1[l], diff_lq2[l], diff_lk2[l],
                            diff_subln[l], lambda_init, rope32)
        x = x + jnp.concatenate([o_mla, o_swa, o_diff], axis=-1) @ w_out[l]
        x = x + hier_moe(rms_norm(x, ffn_norm[l]), router_group[l], router_group_bias[l],
                         router_expert[l], router_expert_bias[l], w_gate[l], w_up[l], w_down[l])
    return rms_norm(x, final_norm)
```

```cpp
#include <hip/hip_runtime.h>
#include <math.h>
#include <stdint.h>

constexpr int D = 1024, NB = 8, S = 2048, T = NB * S, INW = 2080, NL = 2;
constexpr int NE = 32, FF = 256;
constexpr float EPS = 1e-6f;
constexpr int CH = 4096;

__device__ __forceinline__ float wave_sum(float v) {
#pragma unroll
    for (int o = 32; o >= 1; o >>= 1) v += __shfl_xor(v, o);
    return v;
}
__device__ __forceinline__ float wave_max(float v) {
#pragma unroll
    for (int o = 32; o >= 1; o >>= 1) v = fmaxf(v, __shfl_xor(v, o));
    return v;
}

__global__ void k_rope_tables(float2* cs32, float2* cs64) {
    int i = blockIdx.x * blockDim.x + threadIdx.x;
    if (i < S * 16) {
        int s = i / 16, f = i % 16;
        float inv = 1.0f / powf(10000.0f, (float)(2 * f) / 32.0f);
        float ang = (float)s * inv;
        cs32[i] = make_float2((float)cos((double)ang), (float)sin((double)ang));
    }
    if (i < S * 32) {
        int s = i / 32, f = i % 32;
        float inv = 1.0f / powf(10000.0f, (float)(2 * f) / 64.0f);
        float ang = (float)s * inv;
        cs64[i] = make_float2((float)cos((double)ang), (float)sin((double)ang));
    }
}

__global__ __launch_bounds__(256) void k_rowstat(const float* X, int ld, int ncols, float* r, int nrows) {
    int row = (blockIdx.x * 256 + threadIdx.x) >> 6, lane = threadIdx.x & 63;
    if (row >= nrows) return;
    const float* xr = X + (size_t)row * ld;
    float ss = 0.f;
    for (int c = lane * 4; c < ncols; c += 256) { float4 v = *(const float4*)(xr + c); ss += v.x * v.x + v.y * v.y + v.z * v.z + v.w * v.w; }
    ss = wave_sum(ss);
    if (lane == 0) r[row] = rsqrtf(ss / (float)ncols + EPS);
}

#define TM 64
#define TN 64
#define TK 16
#define MAC_TILE(As, Bs, acc) \
    _Pragma("unroll") for (int k = 0; k < TK; ++k) { \
        float4 a = *(const float4*)&As[k][ty * 4]; float4 b = *(const float4*)&Bs[k][tx * 4]; \
        acc[0][0] += a.x * b.x; acc[0][1] += a.x * b.y; acc[0][2] += a.x * b.z; acc[0][3] += a.x * b.w; \
        acc[1][0] += a.y * b.x; acc[1][1] += a.y * b.y; acc[1][2] += a.y * b.z; acc[1][3] += a.y * b.w; \
        acc[2][0] += a.z * b.x; acc[2][1] += a.z * b.y; acc[2][2] += a.z * b.z; acc[2][3] += a.z * b.w; \
        acc[3][0] += a.w * b.x; acc[3][1] += a.w * b.y; acc[3][2] += a.w * b.z; acc[3][3] += a.w * b.w; }

__global__ __launch_bounds__(256) void k_gemm(const float* __restrict__ A, int lda, const float* __restrict__ rs, const float* __restrict__ cg,
                                              const float* __restrict__ B, int ldb, float* C, int ldc, const float* R, int ldr, int N, int K) {
    __shared__ float As[TK][TM + 4], Bs[TK][TN + 4];
    const int tid = threadIdx.x, tx = tid & 15, ty = tid >> 4;
    const int m0 = blockIdx.y * TM, n0 = blockIdx.x * TN;
    const int ar = tid >> 2, ak = (tid & 3) * 4, bk = tid >> 4, bn = (tid & 15) * 4;
    const float* Ap = A + (size_t)(m0 + ar) * lda + ak;
    const float rsv = rs ? rs[m0 + ar] : 1.f;
    float acc[4][4] = {};
    for (int k0 = 0; k0 < K; k0 += TK) {
        float4 a = *(const float4*)(Ap + k0);
        if (cg) { float4 g = *(const float4*)(cg + k0 + ak); a.x = a.x * rsv * g.x; a.y = a.y * rsv * g.y; a.z = a.z * rsv * g.z; a.w = a.w * rsv * g.w; }
        As[ak + 0][ar] = a.x; As[ak + 1][ar] = a.y; As[ak + 2][ar] = a.z; As[ak + 3][ar] = a.w;
        float4 b = make_float4(0.f, 0.f, 0.f, 0.f);
        if (n0 + bn < N) b = *(const float4*)(B + (size_t)(k0 + bk) * ldb + n0 + bn);
        *(float4*)&Bs[bk][bn] = b;
        __syncthreads();
        MAC_TILE(As, Bs, acc)
        __syncthreads();
    }
    const int col = n0 + tx * 4;
    if (col < N) {
#pragma unroll
        for (int i = 0; i < 4; ++i) {
            const int row = m0 + ty * 4 + i;
            float4 v = make_float4(acc[i][0], acc[i][1], acc[i][2], acc[i][3]);
            if (R) { float4 rr = *(const float4*)(R + (size_t)row * ldr + col); v.x += rr.x; v.y += rr.y; v.z += rr.z; v.w += rr.w; }
            *(float4*)(C + (size_t)row * ldc + col) = v;
        }
    }
}

__global__ void k_rope(float* X, int ld, int col0, int nheads, int hstride, int hd, const float2* cs, int nrows) {
    int i = blockIdx.x * blockDim.x + threadIdx.x;
    int half = hd / 2, per_row = nheads * half;
    if (i >= nrows * per_row) return;
    int row = i / per_row, rem = i % per_row, h = rem / half, f = rem % half;
    int s = row % S;
    float2 c = cs[s * half + f];
    float* p = X + (size_t)row * ld + col0 + h * hstride;
    float x1 = p[f], x2 = p[f + half];
    p[f] = x1 * c.x - x2 * c.y;
    p[f + half] = x2 * c.x + x1 * c.y;
}

__global__ void k_build_kmla(const float* kvf, const float* u, float* km, int nrows) {
    int i = blockIdx.x * blockDim.x + threadIdx.x;
    if (i >= nrows * 576) return;
    int row = i / 576, rem = i % 576, h = rem / 96, d = rem % 96;
    km[i] = d < 64 ? kvf[(size_t)row * 768 + h * 128 + d] : u[(size_t)row * INW + 640 + (d - 64)];
}

template <int DQK>
__global__ __launch_bounds__(256) void k_attn(const float* Q, int q_ld, int q_hs, const float* K, int k_ld, int k_hs, int k_grp,
                                              const float* V, int v_ld, int v_hs, int v_grp, float* O, int o_ld, int o_hs,
                                              int window, const float* sink, float scale) {
    __shared__ float qs[4][DQK];
    __shared__ float sc[4][S];
    const int tid = threadIdx.x, q0 = blockIdx.x * 4, h = blockIdx.y, b = blockIdx.z;
    const size_t rowb = (size_t)b * S;
    for (int i = tid; i < 4 * DQK; i += 256) { int qi = i / DQK, d = i % DQK; qs[qi][d] = Q[(rowb + q0 + qi) * q_ld + h * q_hs + d] * scale; }
    int klo = 0, khi = S;
    if (window > 0) { klo = max(0, q0 - window); khi = min(S, q0 + 3 + window + 1); }
    __syncthreads();
    const float* Kb = K + rowb * k_ld + (h / k_grp) * k_hs;
#pragma unroll 1
    for (int j = klo + tid; j < khi; j += 256) {
        asm volatile("" ::: "memory");
        const float4* kr = (const float4*)(Kb + (size_t)j * k_ld);
        float s0 = 0.f, s1 = 0.f, s2 = 0.f, s3 = 0.f;
#pragma unroll
        for (int d4 = 0; d4 < DQK / 4; ++d4) {
            float4 kv = kr[d4];
            float4 a0 = *(const float4*)&qs[0][d4 * 4], a1 = *(const float4*)&qs[1][d4 * 4], a2 = *(const float4*)&qs[2][d4 * 4], a3 = *(const float4*)&qs[3][d4 * 4];
            s0 += a0.x * kv.x + a0.y * kv.y + a0.z * kv.z + a0.w * kv.w;
            s1 += a1.x * kv.x + a1.y * kv.y + a1.z * kv.z + a1.w * kv.w;
            s2 += a2.x * kv.x + a2.y * kv.y + a2.z * kv.z + a2.w * kv.w;
            s3 += a3.x * kv.x + a3.y * kv.y + a3.z * kv.z + a3.w * kv.w;
        }
        if (window > 0) {
            if (abs(q0 + 0 - j) > window) s0 = -INFINITY;
            if (abs(q0 + 1 - j) > window) s1 = -INFINITY;
            if (abs(q0 + 2 - j) > window) s2 = -INFINITY;
            if (abs(q0 + 3 - j) > window) s3 = -INFINITY;
        }
        sc[0][j] = s0; sc[1][j] = s1; sc[2][j] = s2; sc[3][j] = s3;
    }
    __syncthreads();
    const int w = tid >> 6, lane = tid & 63;
    float m = sink ? sink[h] : -INFINITY;
#pragma unroll 2
    for (int j = klo + lane; j < khi; j += 64) m = fmaxf(m, sc[w][j]);
    m = wave_max(m);
    float sum = 0.f;
#pragma unroll 2
    for (int j = klo + lane; j < khi; j += 64) { float p = expf(sc[w][j] - m); sc[w][j] = p; sum += p; }
    sum = wave_sum(sum);
    if (sink) sum += expf(sink[h] - m);
    __syncthreads();
    const float* Vb = V + rowb * v_ld + (h / v_grp) * v_hs + lane;
    float acc = 0.f;
#pragma unroll 8
    for (int j = klo; j < khi; ++j) acc += sc[w][j] * Vb[(size_t)j * v_ld];
    O[(rowb + q0 + w) * o_ld + h * o_hs + lane] = acc / sum;
}

__global__ __launch_bounds__(256) void k_diff_post(const float* otmp, const float* lq1, const float* lk1, const float* lq2, const float* lk2,
                                                   const float* subln, float lambda_init, float* ocat, int nrows) {
    int wv = (blockIdx.x * 256 + threadIdx.x) >> 6, lane = threadIdx.x & 63;
    if (wv >= nrows * 4) return;
    int row = wv >> 2, h = wv & 3;
    float d1 = 0.f, d2 = 0.f;
    for (int i = 0; i < 32; ++i) { d1 += lq1[i] * lk1[i]; d2 += lq2[i] * lk2[i]; }
    float lam = expf(d1) - expf(d2) + lambda_init;
    float o0 = otmp[(size_t)row * 512 + (h * 2 + 0) * 64 + lane], o1 = otmp[(size_t)row * 512 + (h * 2 + 1) * 64 + lane];
    float o = o0 - lam * o1;
    float ss = wave_sum(o * o);
    float r = rsqrtf(ss / 64.f + EPS);
    ocat[(size_t)row * D + 768 + h * 64 + lane] = o * r * subln[lane] * (1.0f - lambda_init);
}

__global__ __launch_bounds__(256) void k_route(const float* X, const float* g, const float* Wrg, const float* brg, const float* Wre, const float* bre,
                                               float* rs, int* slot_e, float* slot_w, int* cnt) {
    const int t = (blockIdx.x * 256 + threadIdx.x) >> 6, lane = threadIdx.x & 63;
    const float* xr = X + (size_t)t * D;
    float xv[16]; float ss = 0.f;
#pragma unroll
    for (int j = 0; j < 4; ++j) { float4 v = *(const float4*)(xr + j * 256 + lane * 4); xv[j * 4 + 0] = v.x; xv[j * 4 + 1] = v.y; xv[j * 4 + 2] = v.z; xv[j * 4 + 3] = v.w; ss += v.x * v.x + v.y * v.y + v.z * v.z + v.w * v.w; }
    ss = wave_sum(ss);
    const float r = rsqrtf(ss / (float)D + EPS);
    if (lane == 0) rs[t] = r;
    float acc[36];
#pragma unroll
    for (int o = 0; o < 36; ++o) acc[o] = 0.f;
#pragma unroll
    for (int j = 0; j < 4; ++j)
#pragma unroll
        for (int c = 0; c < 4; ++c) {
            const int i = j * 256 + lane * 4 + c;
            const float tv = xv[j * 4 + c] * r * g[i];
            float4 wg = *(const float4*)(Wrg + (size_t)i * 4);
            acc[0] += tv * wg.x; acc[1] += tv * wg.y; acc[2] += tv * wg.z; acc[3] += tv * wg.w;
#pragma unroll
            for (int q = 0; q < 8; ++q) { float4 we = *(const float4*)(Wre + (size_t)i * 32 + q * 4); acc[4 + q * 4 + 0] += tv * we.x; acc[4 + q * 4 + 1] += tv * we.y; acc[4 + q * 4 + 2] += tv * we.z; acc[4 + q * 4 + 3] += tv * we.w; }
        }
#pragma unroll
    for (int o = 0; o < 36; ++o) acc[o] = wave_sum(acc[o]);
    float gl[4];
#pragma unroll
    for (int o = 0; o < 4; ++o) gl[o] = acc[o] + brg[o];
    int gi = 0; float gm = gl[0];
#pragma unroll
    for (int o = 1; o < 4; ++o) if (gl[o] > gm) { gm = gl[o]; gi = o; }
    float gs = 0.f;
#pragma unroll
    for (int o = 0; o < 4; ++o) gs += expf(gl[o] - gm);
    const float ggate = 1.0f / gs;
    float ein[8];
#pragma unroll
    for (int i = 0; i < 8; ++i) {
        float v = acc[4 + i] + bre[i];
#pragma unroll
        for (int gg = 1; gg < 4; ++gg) { float v2 = acc[4 + gg * 8 + i] + bre[gg * 8 + i]; v = (gi == gg) ? v2 : v; }
        ein[i] = v;
    }
    int i1 = 0; float v1 = ein[0];
#pragma unroll
    for (int i = 1; i < 8; ++i) if (ein[i] > v1) { v1 = ein[i]; i1 = i; }
    int i2 = -1; float v2 = -INFINITY;
#pragma unroll
    for (int i = 0; i < 8; ++i) if (i != i1 && ein[i] > v2) { v2 = ein[i]; i2 = i; }
    const float e2 = expf(v2 - v1);
    const float w1 = ggate / (1.0f + e2), w2 = ggate * e2 / (1.0f + e2);
    if (lane == 0) {
        slot_e[t * 2 + 0] = gi * 8 + i1; slot_e[t * 2 + 1] = gi * 8 + i2;
        slot_w[t * 2 + 0] = w1; slot_w[t * 2 + 1] = w2;
        atomicAdd(&cnt[gi * 8 + i1], 1); atomicAdd(&cnt[gi * 8 + i2], 1);
    }
}
__global__ void k_scan(const int* cnt, int* off) { if (threadIdx.x == 0) { int a = 0; for (int e = 0; e < NE; ++e) { off[e] = a; a += cnt[e]; } } }
__global__ void k_fill(const int* slot_e, const int* off, int* cur, int* list) {
    int sl = blockIdx.x * blockDim.x + threadIdx.x;
    if (sl >= T * 2) return;
    int e = slot_e[sl]; int p = atomicAdd(&cur[e], 1); list[off[e] + p] = sl;
}

__global__ __launch_bounds__(256) void k_moe_gateup(const float* __restrict__ X, const float* __restrict__ rs, const float* __restrict__ cg,
                                                    const float* __restrict__ Wg, const float* __restrict__ Wu, const int* cnt, const int* off,
                                                    const int* list, const float* slot_w, float* hid) {
    __shared__ float As[TK][TM + 4], Bs[TK][TN + 4], Bs2[TK][TN + 4];
    const int e = blockIdx.z, c = cnt[e], m0 = blockIdx.y * TM;
    if (m0 >= c) return;
    const int base = off[e];
    const int tid = threadIdx.x, tx = tid & 15, ty = tid >> 4, n0 = blockIdx.x * TN;
    const int ar = tid >> 2, ak = (tid & 3) * 4, bk = tid >> 4, bn = (tid & 15) * 4;
    const int pa = min(m0 + ar, c - 1);
    const int tok = list[base + pa] >> 1;
    const float* Ap = X + (size_t)tok * D + ak;
    const float rsv = rs[tok];
    const float* B1 = Wg + (size_t)e * D * FF; const float* B2 = Wu + (size_t)e * D * FF;
    float acc[4][4] = {}, acc2[4][4] = {};
    for (int k0 = 0; k0 < D; k0 += TK) {
        float4 a = *(const float4*)(Ap + k0);
        float4 g = *(const float4*)(cg + k0 + ak);
        a.x = a.x * rsv * g.x; a.y = a.y * rsv * g.y; a.z = a.z * rsv * g.z; a.w = a.w * rsv * g.w;
        As[ak + 0][ar] = a.x; As[ak + 1][ar] = a.y; As[ak + 2][ar] = a.z; As[ak + 3][ar] = a.w;
        *(float4*)&Bs[bk][bn] = *(const float4*)(B1 + (size_t)(k0 + bk) * FF + n0 + bn);
        *(float4*)&Bs2[bk][bn] = *(const float4*)(B2 + (size_t)(k0 + bk) * FF + n0 + bn);
        __syncthreads();
        MAC_TILE(As, Bs, acc)
        MAC_TILE(As, Bs2, acc2)
        __syncthreads();
    }
#pragma unroll
    for (int i = 0; i < 4; ++i) {
        const int p = m0 + ty * 4 + i;
        if (p < c) {
            const float w = slot_w[list[base + p]];
            float4 v;
            float* vp = (float*)&v;
#pragma unroll
            for (int j = 0; j < 4; ++j) { float a = acc[i][j], u = acc2[i][j]; vp[j] = (a / (1.0f + expf(-a))) * u * w; }
            *(float4*)(hid + (size_t)(base + p) * FF + n0 + tx * 4) = v;
        }
    }
}
__global__ __launch_bounds__(256) void k_moe_down(const float* __restrict__ hid, const float* __restrict__ Wd, const int* cnt, const int* off,
                                                  const int* list, float* yslab) {
    __shared__ float As[TK][TM + 4], Bs[TK][TN + 4];
    const int e = blockIdx.z, c = cnt[e], m0 = blockIdx.y * TM;
    if (m0 >= c) return;
    const int base = off[e];
    const int tid = threadIdx.x, tx = tid & 15, ty = tid >> 4, n0 = blockIdx.x * TN;
    const int ar = tid >> 2, ak = (tid & 3) * 4, bk = tid >> 4, bn = (tid & 15) * 4;
    const int pa = min(m0 + ar, c - 1);
    const float* Ap = hid + (size_t)(base + pa) * FF + ak;
    const float* B = Wd + (size_t)e * FF * D;
    float acc[4][4] = {};
    for (int k0 = 0; k0 < FF; k0 += TK) {
        float4 a = *(const float4*)(Ap + k0);
        As[ak + 0][ar] = a.x; As[ak + 1][ar] = a.y; As[ak + 2][ar] = a.z; As[ak + 3][ar] = a.w;
        *(float4*)&Bs[bk][bn] = *(const float4*)(B + (size_t)(k0 + bk) * D + n0 + bn);
        __syncthreads();
        MAC_TILE(As, Bs, acc)
        __syncthreads();
    }
#pragma unroll
    for (int i = 0; i < 4; ++i) {
        const int p = m0 + ty * 4 + i;
        if (p < c) {
            const int slot = list[base + p];
            *(float4*)(yslab + (size_t)slot * D + n0 + tx * 4) = make_float4(acc[i][0], acc[i][1], acc[i][2], acc[i][3]);
        }
    }
}
__global__ void k_combine(float* x1, const float* yslab) {
    size_t i = (size_t)blockIdx.x * blockDim.x + threadIdx.x;
    if (i >= (size_t)T * D / 4) return;
    size_t t = i / (D / 4), c = i % (D / 4);
    float4 a = ((float4*)x1)[i], y0 = ((const float4*)yslab)[(2 * t) * (D / 4) + c], y1 = ((const float4*)yslab)[(2 * t + 1) * (D / 4) + c];
    a.x += y0.x + y1.x; a.y += y0.y + y1.y; a.z += y0.z + y1.z; a.w += y0.w + y1.w;
    ((float4*)x1)[i] = a;
}
__global__ __launch_bounds__(256) void k_final_norm(const float* X, const float* g, float* out) {
    int row = (blockIdx.x * 256 + threadIdx.x) >> 6, lane = threadIdx.x & 63;
    const float* xr = X + (size_t)row * D;
    float4 v[4]; float ss = 0.f;
#pragma unroll
    for (int j = 0; j < 4; ++j) { v[j] = *(const float4*)(xr + j * 256 + lane * 4); ss += v[j].x * v[j].x + v[j].y * v[j].y + v[j].z * v[j].z + v[j].w * v[j].w; }
    ss = wave_sum(ss);
    const float r = rsqrtf(ss / (float)D + EPS);
#pragma unroll
    for (int j = 0; j < 4; ++j) {
        float4 gg = *(const float4*)(g + j * 256 + lane * 4);
        *(float4*)(out + (size_t)row * D + j * 256 + lane * 4) = make_float4(v[j].x * r * gg.x, v[j].y * r * gg.y, v[j].z * r * gg.z, v[j].w * r * gg.w);
    }
}

extern "C" void kernel_launch(void* const* d_in, const int* in_sizes, int n_in, void* d_out, int out_size, void* d_ws, size_t ws_size, hipStream_t stream) {
    const float* x = (const float*)d_in[0];
    const float* attn_norm = (const float*)d_in[1];
    const float* w_in = (const float*)d_in[2];
    const float* mla_q_norm = (const float*)d_in[3];
    const float* mla_kv_norm = (const float*)d_in[4];
    const float* w_uq = (const float*)d_in[5];
    const float* w_ukv = (const float*)d_in[6];
    const float* swa_sink = (const float*)d_in[7];
    const float* lq1 = (const float*)d_in[8];
    const float* lk1 = (const float*)d_in[9];
    const float* lq2 = (const float*)d_in[10];
    const float* lk2 = (const float*)d_in[11];
    const float* subln = (const float*)d_in[12];
    const float* w_out = (const float*)d_in[13];
    const float* ffn_norm = (const float*)d_in[14];
    const float* w_rg = (const float*)d_in[15];
    const float* b_rg = (const float*)d_in[16];
    const float* w_re = (const float*)d_in[17];
    const float* b_re = (const float*)d_in[18];
    const float* w_gate = (const float*)d_in[19];
    const float* w_up = (const float*)d_in[20];
    const float* w_down = (const float*)d_in[21];
    const float* final_norm = (const float*)d_in[22];
    float* out = (float*)d_out;

    char* ws = (char*)d_ws;
    size_t o = 0;
    auto take = [&](size_t bytes) { char* p = ws + o; o += (bytes + 255) & ~(size_t)255; return p; };
    int* ctl = (int*)take(4096);
    int* offs = (int*)take(4096);
    float* rsA = (float*)take(T * 4);
    float* rsF = (float*)take(T * 4);
    float* rsq = (float*)take(CH * 4);
    float* rskv = (float*)take(CH * 4);
    int* slot_e = (int*)take(T * 2 * 4);
    float* slot_w = (float*)take(T * 2 * 4);
    int* list = (int*)take(T * 2 * 4);
    float2* cs32 = (float2*)take(S * 16 * 8);
    float2* cs64 = (float2*)take(S * 32 * 8);
    float* x1 = (float*)take((size_t)T * D * 4);
    float* hid = (float*)take((size_t)T * 2 * FF * 4);
    char* big = ws + o;
    float* ocat = (float*)take((size_t)T * D * 4);
    float* u = (float*)take((size_t)CH * INW * 4);
    float* qf = (float*)take((size_t)CH * 576 * 4);
    float* kvf = (float*)take((size_t)CH * 768 * 4);
    float* km = (float*)take((size_t)CH * 576 * 4);
    float* otmp = (float*)take((size_t)CH * 512 * 4);
    float* yslab = (float*)big;

    hipMemsetAsync(ctl, 0, 4096, stream);
    k_rope_tables<<<(S * 32 + 255) / 256, 256, 0, stream>>>(cs32, cs64);

    const float* xcur = x;
    for (int l = 0; l < NL; ++l) {
        const float lambda_init = 0.8f - 0.6f * expf(-0.3f * (float)l);
        k_rowstat<<<T / 4, 256, 0, stream>>>(xcur, D, D, rsA, T);
        for (int c = 0; c < T / CH; ++c) {
            const size_t r0 = (size_t)c * CH;
            k_gemm<<<dim3((INW + 63) / 64, CH / 64), 256, 0, stream>>>(xcur + r0 * D, D, rsA + r0, attn_norm + l * D, w_in + (size_t)l * D * INW, INW, u, INW, nullptr, 0, INW, D);
            k_rowstat<<<CH / 4, 256, 0, stream>>>(u, INW, 384, rsq, CH);
            k_gemm<<<dim3(576 / 64, CH / 64), 256, 0, stream>>>(u, INW, rsq, mla_q_norm + l * 384, w_uq + (size_t)l * 384 * 576, 576, qf, 576, nullptr, 0, 576, 384);
            k_rowstat<<<CH / 4, 256, 0, stream>>>(u + 384, INW, 256, rskv, CH);
            k_gemm<<<dim3(768 / 64, CH / 64), 256, 0, stream>>>(u + 384, INW, rskv, mla_kv_norm + l * 256, w_ukv + (size_t)l * 256 * 768, 768, kvf, 768, nullptr, 0, 768, 256);
            k_rope<<<(CH * 6 * 16 + 255) / 256, 256, 0, stream>>>(qf, 576, 64, 6, 96, 32, cs32, CH);
            k_rope<<<(CH * 1 * 16 + 255) / 256, 256, 0, stream>>>(u, INW, 640, 1, 0, 32, cs32, CH);
            k_rope<<<(CH * 6 * 32 + 255) / 256, 256, 0, stream>>>(u, INW, 672, 6, 64, 64, cs64, CH);
            k_rope<<<(CH * 2 * 32 + 255) / 256, 256, 0, stream>>>(u, INW, 1056, 2, 64, 64, cs64, CH);
            k_rope<<<(CH * 8 * 16 + 255) / 256, 256, 0, stream>>>(u, INW, 1312, 8, 32, 32, cs32, CH);
            k_rope<<<(CH * 8 * 16 + 255) / 256, 256, 0, stream>>>(u, INW, 1568, 8, 32, 32, cs32, CH);
            k_build_kmla<<<(CH * 576 + 255) / 256, 256, 0, stream>>>(kvf, u, km, CH);
            float* oc = ocat + r0 * D;
            k_attn<96><<<dim3(S / 4, 6, CH / S), 256, 0, stream>>>(qf, 576, 96, km, 576, 96, 1, kvf + 64, 768, 128, 1, oc, D, 64, -1, nullptr, 1.0f / sqrtf(96.f));
            k_attn<64><<<dim3(S / 4, 6, CH / S), 256, 0, stream>>>(u + 672, INW, 64, u + 1056, INW, 64, 3, u + 1184, INW, 64, 3, oc + 384, D, 64, 128, swa_sink + l * 6, 0.125f);
            k_attn<32><<<dim3(S / 4, 8, CH / S), 256, 0, stream>>>(u + 1312, INW, 32, u + 1568, INW, 32, 1, u + 1824, INW, 64, 2, otmp, 512, 64, -1, nullptr, 1.0f / sqrtf(32.f));
            k_diff_post<<<CH * 4 / 4, 256, 0, stream>>>(otmp, lq1 + l * 32, lk1 + l * 32, lq2 + l * 32, lk2 + l * 32, subln + l * 64, lambda_init, oc, CH);
        }
        k_gemm<<<dim3(D / 64, T / 64), 256, 0, stream>>>(ocat, D, nullptr, nullptr, w_out + (size_t)l * D * D, D, x1, D, xcur, D, D, D);
        xcur = x1;
        int* cnt = ctl + l * 64; int* cur = ctl + l * 64 + 32; int* off = offs + l * 32;
        k_route<<<T / 4, 256, 0, stream>>>(x1, ffn_norm + l * D, w_rg + (size_t)l * D * 4, b_rg + l * 4, w_re + (size_t)l * D * 32, b_re + l * 32, rsF, slot_e, slot_w, cnt);
        k_scan<<<1, 64, 0, stream>>>(cnt, off);
        k_fill<<<T * 2 / 256, 256, 0, stream>>>(slot_e, off, cur, list);
        k_moe_gateup<<<dim3(FF / 64, T * 2 / 64, NE), 256, 0, stream>>>(x1, rsF, ffn_norm + l * D, w_gate + (size_t)l * NE * D * FF, w_up + (size_t)l * NE * D * FF, cnt, off, list, slot_w, hid);
        k_moe_down<<<dim3(D / 64, T * 2 / 64, NE), 256, 0, stream>>>(hid, w_down + (size_t)l * NE * FF * D, cnt, off, list, yslab);
        k_combine<<<T * D / 4 / 256, 256, 0, stream>>>(x1, yslab);
    }
    k_final_norm<<<T / 4, 256, 0, stream>>>(x1, final_norm, out);
}
```

```cpp
#include <hip/hip_runtime.h>
#include <math.h>
#include <stdint.h>
#include <cstdio>
constexpr int D = 1024, NB = 8, S = 2048, T = NB * S, INW = 2080, NL = 2;
constexpr int NE = 32, FF = 256;
constexpr float EPS = 1e-6f;

__device__ __forceinline__ float wave_sum(float v) {
#pragma unroll
    for (int o = 32; o >= 1; o >>= 1) v += __shfl_xor(v, o);
    return v;
}
__device__ __forceinline__ float wave_max(float v) {
#pragma unroll
    for (int o = 32; o >= 1; o >>= 1) v = fmaxf(v, __shfl_xor(v, o));
    return v;
}
namespace pg8 {
#define PG8_LAS __attribute__((address_space(3)))
typedef unsigned short bf16_t;
typedef short bf16x8 __attribute__((ext_vector_type(8)));
typedef float f32x4 __attribute__((ext_vector_type(4)));
typedef unsigned u32x4 __attribute__((ext_vector_type(4)));
typedef unsigned u32x2 __attribute__((ext_vector_type(2)));
constexpr int BM = 256, BK = 64, HALF = 128, HTB = HALF * BK * 2  , STAGE_BYTES = 8 * HTB;

__device__ __forceinline__ int lds_byte(int r, int c) { const int st = (r >> 4) * 2 + (c >> 5), rr = r & 15, cc = c & 31, ob = rr * 64 + cc * 2; return st * 1024 + (ob ^ (((ob >> 9) & 1) << 5)); }
__device__ __forceinline__ void stage_rc(int b, int& R, int& C) { const int st = b / 1024, sb = b % 1024, swz = sb ^ (((sb >> 9) & 1) << 5); R = (st >> 1) * 16 + swz / 64; C = (st & 1) * 32 + (swz % 64) / 2; }
__device__ __forceinline__ int perm32(int rho) { const int n = rho >> 4, i = rho & 15; return 8 * (i >> 2) + 4 * n + (i & 3); }

struct Unit { int pm, pn, e, cnt; };
struct Gemm { const bf16_t* A; const bf16_t* Bt; int lda, ldb, K; };

__device__ __forceinline__ unsigned cvt_pk_bf16(float lo, float hi) {
    typedef float f2 __attribute__((ext_vector_type(2))); typedef __bf16 b2 __attribute__((ext_vector_type(2)));
    f2 v = {lo, hi}; b2 b = __builtin_convertvector(v, b2); return __builtin_bit_cast(unsigned, b);
}

__device__ __forceinline__ void stage2(PG8_LAS unsigned char* lds, int bufoff, unsigned ldsw, const char* gbase, const unsigned (&voff)[2], size_t kb) {
#pragma unroll
    for (int i = 0; i < 2; ++i)
        __builtin_amdgcn_global_load_lds((const unsigned*)(gbase + voff[i] + kb), (PG8_LAS unsigned*)(lds + bufoff + ldsw + i * 8192), 16, 0, 0);
}

template <class Epi, class Sched, bool ALIGN_EPI>
__device__ __forceinline__ void gemm_phase(PG8_LAS unsigned char* lds, const Gemm g, const Sched& S, const Epi& E, const int wid, const int lane) {
    const int tid = wid * 64 + lane, wr = wid >> 2, wc = wid & 3, fr = lane & 15, fq = lane >> 4;
    const int K = g.K, nt = K / BK;
    unsigned voffB[2];
#pragma unroll
    for (int i = 0; i < 2; ++i) { int R, C; stage_rc(tid * 16 + i * 8192, R, C); const int Rb = Epi::PERM ? ((R & ~31) + perm32(R & 31)) : R;
        voffB[i] = (unsigned)(Rb * g.ldb + C) * 2u; }
    const size_t kstep = (size_t)(BK * 2);
    const size_t hstepB = (size_t)HALF * g.ldb * 2;
    const unsigned ldsw = (unsigned)wid * 1024u;
    const int aoff = lds_byte(wr * 64 + fr, fq * 8), boff = lds_byte(wc * 32 + fr, fq * 8);
    const char* Ab = (const char*)g.A;
#define PG8_SA(b, h) (((b) * 2 + (h)) * HTB)
#define PG8_SB(b, h) ((4 + (b) * 2 + (h)) * HTB)
#define PG8_STAGE(bufoff, gbase, voff, kb) stage2(lds, (bufoff), ldsw, (gbase), (voff), (kb))
#define PG8_LDA(dst, b, h) do { _Pragma("unroll") for (int m = 0; m < 4; ++m) _Pragma("unroll") for (int k = 0; k < 2; ++k) dst[m][k] = *(const PG8_LAS bf16x8*)(lds + PG8_SA(b, h) + aoff + m * 2048 + k * 1024); } while (0)
#define PG8_LDB(dst, b, h) do { _Pragma("unroll") for (int n = 0; n < 2; ++n) _Pragma("unroll") for (int k = 0; k < 2; ++k) dst[n][k] = *(const PG8_LAS bf16x8*)(lds + PG8_SB(b, h) + boff + n * 2048 + k * 1024); } while (0)
#define PG8_MMA(ai, bj, At, Bt) do { __builtin_amdgcn_s_setprio(1); _Pragma("unroll") for (int m = 0; m < 4; ++m) _Pragma("unroll") for (int n = 0; n < 2; ++n) _Pragma("unroll") for (int k = 0; k < 2; ++k) \
        acc[ai][bj][m][n] = __builtin_amdgcn_mfma_f32_16x16x32_bf16(Bt[n][k], At[m][k], acc[ai][bj][m][n], 0, 0, 0); __builtin_amdgcn_s_setprio(0); } while (0)
#define PG8_WAIT_V(n) asm volatile("s_waitcnt vmcnt(" #n ")" ::: "memory")
#define PG8_WAIT_L(n) asm volatile("s_waitcnt lgkmcnt(" #n ")" ::: "memory")
#define PG8_BAR __builtin_amdgcn_s_barrier()
#define PG8_SCHED __builtin_amdgcn_sched_barrier(0)
#define PG8_MKOFF(u, d0, d1) do { _Pragma("unroll") for (int _i = 0; _i < 2; ++_i) { int _R, _C; stage_rc(tid * 16 + _i * 8192, _R, _C); d0[_i] = (S.arow(u, _R) * (unsigned)g.lda + (unsigned)_C) * 2u; d1[_i] = (S.arow(u, HALF + _R) * (unsigned)g.lda + (unsigned)_C) * 2u; } } while (0)
    Unit cur, nxt; int ui = 0;
    if (!S.next(0, cur)) return;
    f32x4 acc[2][2][4][2];
#pragma unroll
    for (int a = 0; a < 2; ++a)
#pragma unroll
        for (int b = 0; b < 2; ++b)
#pragma unroll
            for (int m = 0; m < 4; ++m)
#pragma unroll
                for (int n = 0; n < 2; ++n) acc[a][b][m][n] = (f32x4){0.f, 0.f, 0.f, 0.f};
    bf16x8 At[4][2], B0[2][2], B1[2][2];
    unsigned o0[2], o1[2], n0[2], n1[2];
    PG8_MKOFF(cur, o0, o1);
    const char* cB = (const char*)S.bbase(cur);
    PG8_STAGE(PG8_SB(0, 0), cB, voffB, 0); PG8_STAGE(PG8_SB(0, 1), cB + hstepB, voffB, 0); PG8_STAGE(PG8_SA(0, 0), Ab, o0, 0); PG8_STAGE(PG8_SA(0, 1), Ab, o1, 0);
    if (wr == 1) PG8_BAR;
    PG8_WAIT_V(2); PG8_BAR;
    PG8_STAGE(PG8_SB(1, 0), cB, voffB, kstep); PG8_STAGE(PG8_SA(1, 0), Ab, o0, kstep); PG8_STAGE(PG8_SB(1, 1), cB + hstepB, voffB, kstep);
    PG8_WAIT_V(6); PG8_BAR;
    for (;;) {
        const bool has_next = S.next(ui + 1, nxt);
        const char* nB = cB;
        if (has_next) { PG8_MKOFF(nxt, n0, n1); nB = (const char*)S.bbase(nxt); }
        else {
#pragma unroll
            for (int i = 0; i < 2; ++i) { n0[i] = o0[i]; n1[i] = o1[i]; } }
#pragma unroll 1
        for (int t = 0; t < nt; t += 2) {
            const bool last = (t == nt - 2);
            const size_t a1k = (size_t)(t + 1) * kstep;
            unsigned x0[2], x1[2];
#pragma unroll
            for (int i = 0; i < 2; ++i) { x0[i] = last ? n0[i] : o0[i]; x1[i] = last ? n1[i] : o1[i]; }
            const size_t k2 = last ? 0 : (size_t)(t + 2) * kstep, k3 = k2 + kstep;
            const char* b2 = last ? nB : cB;
            PG8_LDB(B0, 0, 0); PG8_LDB(B1, 0, 1); PG8_SCHED; PG8_LDA(At, 0, 0); PG8_STAGE(PG8_SA(1, 1), Ab, o1, a1k);
            PG8_WAIT_V(8); PG8_WAIT_L(0); PG8_BAR; PG8_MMA(0, 0, At, B0); PG8_MMA(0, 1, At, B1); PG8_BAR; PG8_SCHED;
            PG8_LDA(At, 0, 1); PG8_STAGE(PG8_SB(0, 0), b2, voffB, k2); PG8_STAGE(PG8_SB(0, 1), b2 + hstepB, voffB, k2); PG8_STAGE(PG8_SA(0, 0), Ab, x0, k2);
            PG8_WAIT_V(8); PG8_WAIT_L(0); PG8_BAR; PG8_MMA(1, 0, At, B0); PG8_MMA(1, 1, At, B1); PG8_BAR; PG8_SCHED;
            PG8_LDB(B0, 1, 0); PG8_LDB(B1, 1, 1); PG8_SCHED; PG8_LDA(At, 1, 0); PG8_STAGE(PG8_SA(0, 1), Ab, x1, k2);
            PG8_WAIT_V(8); PG8_WAIT_L(0); PG8_BAR; PG8_MMA(0, 0, At, B0); PG8_MMA(0, 1, At, B1); PG8_BAR; PG8_SCHED;
            PG8_LDA(At, 1, 1); PG8_STAGE(PG8_SB(1, 0), b2, voffB, k3); PG8_STAGE(PG8_SB(1, 1), b2 + hstepB, voffB, k3); PG8_STAGE(PG8_SA(1, 0), Ab, x0, k3);
            PG8_WAIT_V(8); PG8_WAIT_L(0); PG8_BAR; PG8_MMA(1, 0, At, B0); PG8_MMA(1, 1, At, B1); PG8_BAR; PG8_SCHED;
        }
        if constexpr (ALIGN_EPI) { if (wr == 0) PG8_BAR; }
        E(acc, cur, wr, wc, fr, fq);
        if (!has_next) break;
#pragma unroll
        for (int a = 0; a < 2; ++a)
#pragma unroll
            for (int b = 0; b < 2; ++b)
#pragma unroll
                for (int m = 0; m < 4; ++m)
#pragma unroll
                    for (int n = 0; n < 2; ++n) acc[a][b][m][n] = (f32x4){0.f, 0.f, 0.f, 0.f};
        cur = nxt; cB = nB; ++ui;
#pragma unroll
        for (int i = 0; i < 2; ++i) { o0[i] = n0[i]; o1[i] = n1[i]; }
        if constexpr (ALIGN_EPI) { if (wr == 1) PG8_BAR; }
    }
    PG8_WAIT_V(0);
    if constexpr (!ALIGN_EPI) { if (wr == 0) PG8_BAR; }
    PG8_BAR;
#undef PG8_SA
#undef PG8_SB
#undef PG8_STAGE
#undef PG8_LDA
#undef PG8_LDB
#undef PG8_MMA
#undef PG8_WAIT_V
#undef PG8_WAIT_L
#undef PG8_BAR
#undef PG8_SCHED
#undef PG8_MKOFF
}
}
namespace att {
typedef short bf16x8 __attribute__((ext_vector_type(8)));
typedef short s16x4 __attribute__((ext_vector_type(4)));
typedef float f32x16 __attribute__((ext_vector_type(16)));
typedef __attribute__((address_space(3))) unsigned char* ldsp;
constexpr int KSLOT = 12288, VSLOT = 8192, K_OFF = 0, V_OFF = 2 * KSLOT, WS_OFF = V_OFF + 2 * VSLOT, ATT_LDS = WS_OFF + 8 * 1024;
constexpr float LOG2E = 1.4426950408889634f;
constexpr float THR = 8.0f;

struct AttnP {
    const unsigned short* Q; int qp, qc, qhs;
    const unsigned short* K; int kp, kc, khs, kgrp;
    const unsigned short* K2; int k2p;
    const unsigned short* V; int vp, vc, vhs, vgrp;
    unsigned short* O; int op, oc, ohs;
    const float* sink;
    float lam, omli; const float* subln;
};

__device__ __forceinline__ int crow(int r, int hi) { return (r & 3) + 8 * (r >> 2) + 4 * hi; }
__device__ __forceinline__ s16x4 vtr(const __attribute__((address_space(3))) unsigned char* p) {
    typedef short v4i16_t __attribute__((ext_vector_type(4)));
    return __builtin_bit_cast(s16x4, __builtin_amdgcn_ds_read_tr16_b64_v4i16((__attribute__((address_space(3))) v4i16_t*)p));
}
#define ATT_WAIT_BAR() asm volatile("s_waitcnt vmcnt(0) lgkmcnt(0)\n\ts_barrier" ::: "memory")

template <int MIX>
__device__ __forceinline__ void attn_unit(const AttnP& P, int b, int h, int qb, ldsp lds, int wid, int lane) {
    constexpr int NC = (MIX == 2) ? 2 : 1;
    constexpr int ND = (MIX == 0) ? 6 : (MIX == 1) ? 4 : 2;
    constexpr int NKP = (MIX == 0) ? 12 : 8;
    const int r32 = lane & 31, hi = lane >> 5;
    const int q0 = qb * 256;
    const size_t rowb = (size_t)b * S;
    int kt0 = 0, nt = S / 64;
    if (MIX == 1) { const int klo = max(0, q0 - 128), khi = min(S, q0 + 256 + 128); kt0 = klo / 64; nt = (khi - klo) / 64; }
    bf16x8 qf[NC][ND];
    {
        const unsigned short* qrow = P.Q + (rowb + q0 + wid * 32 + r32) * P.qp + P.qc + h * P.qhs + hi * 8;
#pragma unroll
        for (int c = 0; c < NC; ++c)
#pragma unroll
            for (int d0 = 0; d0 < ND; ++d0) qf[c][d0] = *(const bf16x8*)(qrow + c * (ND * 16) + d0 * 16);
    }
    const unsigned short* Kb = P.K + rowb * P.kp + P.kc + (h / P.kgrp) * P.khs;
    const unsigned short* K2b = (MIX == 0) ? P.K2 + rowb * P.k2p : nullptr;
    const unsigned short* Vb = P.V + rowb * P.vp + P.vc + (h / P.vgrp) * P.vhs;
    __attribute__((address_space(3))) float* wsf = (__attribute__((address_space(3))) float*)(lds + WS_OFF) + wid * 256;
    constexpr bool NEGM = (MIX != 2);
    float mhat[NC], lsum[NC]; f32x16 o[NC][2], negm[NEGM ? NC : 1];
#pragma unroll
    for (int c = 0; c < NC; ++c) {
        mhat[c] = 0.f; lsum[c] = 0.f;
        if (MIX == 1) { mhat[c] = P.sink[h] * LOG2E; lsum[c] = (hi == 0) ? 1.f : 0.f; }
#pragma unroll
        for (int r = 0; r < 16; ++r) { o[c][0][r] = 0.f; o[c][1][r] = 0.f; if (NEGM) negm[c][r] = -mhat[c]; }
    }
    auto issue = [&](int j, int slot) {
        const size_t krow = (size_t)(kt0 + j) * 64;
#pragma unroll
        for (int pp = 0; pp < 3; ++pp) {
            const int p = wid + pp * 8;
            if (p < NKP + 8) {
                const unsigned short* src; unsigned dst;
                if (p < NKP) {
                    if (MIX == 0 && p >= 8) src = K2b + (krow + lane) * P.k2p + (p - 8) * 8;
                    else src = Kb + (krow + lane) * P.kp + p * 8;
                    dst = K_OFF + slot * KSLOT + p * 1024;
                } else {
                    const int pv = p - NKP, d0 = pv >> 2, ks = pv & 3;
                    src = Vb + (krow + 16 * ks + (lane >> 2)) * P.vp + d0 * 32 + (lane & 3) * 8;
                    dst = V_OFF + slot * VSLOT + pv * 1024;
                }
                __builtin_amdgcn_global_load_lds((const unsigned*)src, (__attribute__((address_space(3))) unsigned*)(lds + dst), 16, 0, 0);
            }
        }
    };
    const int voff = (4 * hi + ((lane & 15) >> 2)) * 64 + ((lane >> 4) & 1) * 32 + (lane & 3) * 8;
    auto compute = [&](int j, int slot, bool first) {
        const ldsp Ks = lds + K_OFF + slot * KSLOT, Vs = lds + V_OFF + slot * VSLOT;
        bf16x8 pw[NC][4];
#pragma unroll
        for (int c = 0; c < NC; ++c) {
            f32x16 p0, p1;
            if (NEGM) { p0 = negm[c]; p1 = negm[c]; }
            else {
#pragma unroll
                for (int r = 0; r < 16; ++r) { p0[r] = 0.f; p1[r] = 0.f; } }
#pragma unroll
            for (int d0 = 0; d0 < ND; ++d0) {
                const bf16x8 a0 = *(const __attribute__((address_space(3))) bf16x8*)(Ks + (c * 2 * ND + 2 * d0 + hi) * 1024 + r32 * 16);
                const bf16x8 a1 = *(const __attribute__((address_space(3))) bf16x8*)(Ks + (c * 2 * ND + 2 * d0 + hi) * 1024 + 512 + r32 * 16);
                p0 = __builtin_amdgcn_mfma_f32_32x32x16_bf16(a0, qf[c][d0], p0, 0, 0, 0);
                p1 = __builtin_amdgcn_mfma_f32_32x32x16_bf16(a1, qf[c][d0], p1, 0, 0, 0);
            }
            if (!NEGM) {
#pragma unroll
                for (int r = 0; r < 16; ++r) { p0[r] -= mhat[c]; p1[r] -= mhat[c]; } }
            if (MIX == 1) {
                const int q = q0 + wid * 32 + r32, kb = (kt0 + j) * 64;
#pragma unroll
                for (int r = 0; r < 16; ++r) { const int k0 = kb + crow(r, hi), k1 = k0 + 32;
                    if (k0 < q - 128 || k0 > q + 128) p0[r] = -INFINITY;
                    if (k1 < q - 128 || k1 > q + 128) p1[r] = -INFINITY; }
            }
            float rm = fmaxf(p0[0], p1[0]);
#pragma unroll
            for (int r = 1; r < 16; ++r) rm = fmaxf(rm, fmaxf(p0[r], p1[r]));
            rm = fmaxf(rm, __shfl_xor(rm, 32));
            const bool trig = first || __any(rm > THR);
            if (trig) {
                const float dl = first ? rm : fmaxf(rm, 0.f);
                mhat[c] += dl;
#pragma unroll
                for (int r = 0; r < 16; ++r) { p0[r] -= dl; p1[r] -= dl; if (NEGM) negm[c][r] = -mhat[c]; }
                if (!first) {
                    const float f = __builtin_amdgcn_exp2f(-dl);
                    lsum[c] *= f;
                    if (hi == 0) wsf[r32] = f;
                    asm volatile("s_waitcnt lgkmcnt(0)" ::: "memory");
#pragma unroll
                    for (int r = 0; r < 16; ++r) { const float fr_ = wsf[crow(r, hi)]; o[c][0][r] *= fr_; o[c][1][r] *= fr_; }
                    asm volatile("s_waitcnt lgkmcnt(0)" ::: "memory");
                }
            }
            float sacc = 0.f;
#pragma unroll
            for (int r = 0; r < 16; ++r) { p0[r] = __builtin_amdgcn_exp2f(p0[r]); p1[r] = __builtin_amdgcn_exp2f(p1[r]); sacc += p0[r] + p1[r]; }
            lsum[c] += sacc;
            {
                unsigned w[16];
#pragma unroll
                for (int i = 0; i < 8; ++i) { w[i] = pg8::cvt_pk_bf16(p0[2 * i], p0[2 * i + 1]); w[8 + i] = pg8::cvt_pk_bf16(p1[2 * i], p1[2 * i + 1]); }
#pragma unroll
                for (int ks = 0; ks < 4; ++ks) { pg8::u32x4 t = {w[4 * ks], w[4 * ks + 1], w[4 * ks + 2], w[4 * ks + 3]}; pw[c][ks] = __builtin_bit_cast(bf16x8, t); }
            }
        }
#pragma unroll
        for (int d0v = 0; d0v < 2; ++d0v) {
            s16x4 vlo[4], vhi[4];
#pragma unroll
            for (int ks = 0; ks < 4; ++ks) { vlo[ks] = vtr(Vs + d0v * 4096 + ks * 1024 + voff); vhi[ks] = vtr(Vs + d0v * 4096 + ks * 1024 + 512 + voff); }
#pragma unroll
            for (int ks = 0; ks < 4; ++ks) {
                const bf16x8 vf = {vlo[ks][0], vlo[ks][1], vlo[ks][2], vlo[ks][3], vhi[ks][0], vhi[ks][1], vhi[ks][2], vhi[ks][3]};
#pragma unroll
                for (int c = 0; c < NC; ++c) o[c][d0v] = __builtin_amdgcn_mfma_f32_32x32x16_bf16(pw[c][ks], vf, o[c][d0v], 0, 0, 0);
            }
        }
    };
    issue(0, 0);
    ATT_WAIT_BAR();
    if (nt > 1) issue(1, 1);
    compute(0, 0, MIX != 1);
    ATT_WAIT_BAR();
#pragma unroll 1
    for (int j = 1; j < nt; ++j) {
        if (j + 1 < nt) issue(j + 1, (j + 1) & 1);
        compute(j, j & 1, false);
        ATT_WAIT_BAR();
    }
    float rl[NC][16];
#pragma unroll
    for (int c = 0; c < NC; ++c) {
        const float lt = lsum[c] + __shfl_xor(lsum[c], 32);
        if (hi == 0) wsf[32 + c * 32 + r32] = lt;
    }
    asm volatile("s_waitcnt lgkmcnt(0)" ::: "memory");
#pragma unroll
    for (int c = 0; c < NC; ++c)
#pragma unroll
        for (int r = 0; r < 16; ++r) rl[c][r] = 1.0f / wsf[32 + c * 32 + crow(r, hi)];
    asm volatile("s_waitcnt lgkmcnt(0)" ::: "memory");
    unsigned short* Ow = P.O + (rowb + q0 + wid * 32) * P.op + P.oc + h * P.ohs + r32;
    if (MIX != 2) {
#pragma unroll
        for (int r = 0; r < 16; ++r)
#pragma unroll
            for (int d0v = 0; d0v < 2; ++d0v) Ow[(size_t)crow(r, hi) * P.op + d0v * 32] = (unsigned short)(pg8::cvt_pk_bf16(o[0][d0v][r] * rl[0][r], 0.f) & 0xffffu);
    } else {
        const float g0 = P.subln[r32] * P.omli, g1 = P.subln[32 + r32] * P.omli;
#pragma unroll
        for (int r = 0; r < 16; ++r) {
            const float v0 = o[0][0][r] * rl[0][r] - P.lam * (o[NC - 1][0][r] * rl[NC - 1][r]);
            const float v1 = o[0][1][r] * rl[0][r] - P.lam * (o[NC - 1][1][r] * rl[NC - 1][r]);
            float ss = v0 * v0 + v1 * v1;
            ss += __shfl_xor(ss, 1); ss += __shfl_xor(ss, 2); ss += __shfl_xor(ss, 4); ss += __shfl_xor(ss, 8); ss += __shfl_xor(ss, 16);
            const float rr = rsqrtf(ss * (1.0f / 64.0f) + EPS);
            Ow[(size_t)crow(r, hi) * P.op] = (unsigned short)(pg8::cvt_pk_bf16(v0 * rr * g0, 0.f) & 0xffffu);
            Ow[(size_t)crow(r, hi) * P.op + 32] = (unsigned short)(pg8::cvt_pk_bf16(v1 * rr * g1, 0.f) & 0xffffu);
        }
    }
}
}
#define GAS __attribute__((address_space(1)))
#define LAS __attribute__((address_space(3)))
typedef unsigned short bf16;
typedef unsigned v4u __attribute__((ext_vector_type(4)));
typedef unsigned v2u __attribute__((ext_vector_type(2)));
typedef float f32x4 __attribute__((ext_vector_type(4)));
constexpr int NWAVES = 8;
constexpr int LDS_BYTES = 147456;
constexpr int LDS_MISC = 131072;
#define LDS_WAIT() asm volatile("s_waitcnt lgkmcnt(0)" ::: "memory")
#define VM_WAIT() asm volatile("s_waitcnt vmcnt(0)" ::: "memory")
__device__ __forceinline__ unsigned pk2(float lo, float hi) { return pg8::cvt_pk_bf16(lo, hi); }
__device__ __forceinline__ bf16 f2bf(float v) { return (bf16)(pg8::cvt_pk_bf16(v, 0.f) & 0xffffu); }
__device__ __forceinline__ float bf2f(unsigned short b) { return __uint_as_float((unsigned)b << 16); }
constexpr float LOG2E = 1.4426950408889634f;

struct Args {
    const float* in[23];
    float* out;
    unsigned char* ws;
    int phase, layer, pad0, pad1;
};
constexpr size_t MiB = 1u << 20, KiB = 1u << 10;
constexpr size_t WS_CTL = 0;
constexpr size_t CTL_CNT = 0;
constexpr size_t CTL_BAR = 512 * KiB;
constexpr size_t WS_RA = 1 * MiB;
constexpr size_t WS_RF = WS_RA + 64 * KiB;
constexpr size_t WS_KROPE = WS_RF + 64 * KiB;
constexpr size_t WS_CS32 = WS_KROPE + 1 * MiB;
constexpr size_t WS_CS64 = WS_CS32 + 256 * KiB;
constexpr size_t WS_SLOTW = 3 * MiB;
constexpr size_t WS_SSQP = 3 * MiB + 256 * KiB;
constexpr size_t WS_LIST = 5 * MiB;
constexpr int LCAP = 16384;
constexpr size_t WS_WSMALL = 7 * MiB;
constexpr size_t WSM_LAYER = 7 * MiB, WSM_IN = 0, WSM_UQ = 4 * MiB, WSM_UKV = 4 * MiB + 640 * KiB, WSM_OUT = 5 * MiB;
constexpr size_t WS_WGU = 21 * MiB;
constexpr size_t WS_WD = 53 * MiB;
constexpr size_t WS_XB = 69 * MiB;
constexpr size_t WS_XA = 101 * MiB;
constexpr size_t WS_U = 165 * MiB;
constexpr size_t WS_QM = 229 * MiB;
constexpr size_t WS_KVM = 247 * MiB;
constexpr size_t WS_END = 271 * MiB;

__device__ __forceinline__ int lane_id() { return (int)__builtin_amdgcn_mbcnt_hi(~0u, __builtin_amdgcn_mbcnt_lo(~0u, 0u)); }
typedef const __attribute__((address_space(4))) Args* AP;
__device__ __forceinline__ AP launder(AP p) { asm volatile("" : "+s"(p)); return p; }
struct Frame {
    LAS unsigned char* lds;
    int wave, vcu, G;
    __device__ __forceinline__ int lane_() const { return lane_id(); }
};
#define F_LANE (F.lane_())
#define F_TID (F.wave * 64 + F.lane_())

__device__ __forceinline__ void transpose_item2(const float* srcA, int cA, const float* srcB, int cB, int ldw, const float* gain, bf16* WT, int ldt, int k0, int n0d, LAS float* scr, int lane) {
    const int j = lane & 31; const float* sp = (j < 16) ? srcA + cA + j : srcB + cB + (j - 16);
#pragma unroll 8
    for (int i = 0; i < 32; ++i) { const int kk = 2 * i + (lane >> 5); float v = sp[(size_t)(k0 + kk) * ldw]; if (gain) v *= gain[k0 + kk]; scr[kk * 33 + j] = v; }
    LDS_WAIT(); asm volatile("" ::: "memory");
    const int c = lane & 7;
#pragma unroll
    for (int jj = 0; jj < 4; ++jj) { const int n = (lane >> 3) + 8 * jj; const LAS float* s = scr + (8 * c) * 33 + n;
        v4u o; o.x = pk2(s[0 * 33], s[1 * 33]); o.y = pk2(s[2 * 33], s[3 * 33]); o.z = pk2(s[4 * 33], s[5 * 33]); o.w = pk2(s[6 * 33], s[7 * 33]);
        *(GAS v4u*)(WT + (size_t)(n0d + n) * ldt + k0 + 8 * c) = o; }
    LDS_WAIT(); asm volatile("" ::: "memory");
}
__device__ __forceinline__ void ucol_src(int G32, int& cA, int& cB) {
    const int c = G32 * 32;
    if (c < 640) { cA = c; cB = c + 16; }
    else if (c < 1152) {
        const int rel = c - 640, hh = rel / 64, gi = (rel % 64) / 32; const int base = 672 + hh * 64;
        cA = base + 16 * gi; cB = base + 32 + 16 * gi; }
    else { cA = c + 32; cB = c + 48; }
}
__device__ __forceinline__ void p0_small(const Frame& F, AP a) {
    LAS float* scr = (LAS float*)(F.lds + F.wave * 16384);
    const int gw = F.vcu * NWAVES + F.wave, NGW = F.G * NWAVES;
    constexpr int I_IN = 16 * 64, I_UQ = 6 * 24, I_UKV = 4 * 24, I_OUT = 16 * 32, I_L = I_IN + I_UQ + I_UKV + I_OUT;
#pragma unroll 1
    for (int it = gw; it < 2 * I_L; it += NGW) {
        const int l = it / I_L; int r = it % I_L;
        unsigned char* wl = a->ws + WS_WSMALL + (size_t)l * WSM_LAYER;
        if (r < I_IN) { const int kb = r / 64, nb = r % 64; int cA, cB; ucol_src(nb, cA, cB); const float* W = a->in[2] + (size_t)l * D * INW;
            transpose_item2(W, cA, W, cB, INW, a->in[1] + l * D, (bf16*)(wl + WSM_IN), 1024, kb * 64, nb * 32, scr, F_LANE); continue; }
        r -= I_IN;
        if (r < I_UQ) { const int kb = r / 24, nb = r % 24; bf16* WT = (bf16*)(wl + WSM_UQ);
            if (nb < 18) { const float* W = a->in[5] + (size_t)l * 384 * 576; transpose_item2(W, nb * 32, W, nb * 32 + 16, 576, a->in[3] + l * 384, WT, 384, kb * 64, nb * 32, scr, F_LANE); }
            else { for (int n = 0; n < 32; ++n) WT[(size_t)(nb * 32 + n) * 384 + kb * 64 + F_LANE] = 0; }
            continue; }
        r -= I_UQ;
        if (r < I_UKV) { const int kb = r / 24, nb = r % 24; const float* W = a->in[6] + (size_t)l * 256 * 768;
            transpose_item2(W, nb * 32, W, nb * 32 + 16, 768, a->in[4] + l * 256, (bf16*)(wl + WSM_UKV), 256, kb * 64, nb * 32, scr, F_LANE); continue; }
        r -= I_UKV;
        { const int kb = r / 32, nb = r % 32; const float* W = a->in[13] + (size_t)l * D * D;
            transpose_item2(W, nb * 32, W, nb * 32 + 16, D, nullptr, (bf16*)(wl + WSM_OUT), 1024, kb * 64, nb * 32, scr, F_LANE); }
    }
    float2* cs32 = (float2*)(a->ws + WS_CS32); float2* cs64 = (float2*)(a->ws + WS_CS64);
#pragma unroll 1
    for (int i = F.vcu * 512 + F_TID; i < S * 32; i += F.G * 512) {
        { const int s = i / 32, f = i % 32; const float inv = 1.0f / powf(10000.0f, (float)(2 * f) / 64.0f); const float ang = (float)s * inv;
          cs64[i] = make_float2((float)cos((double)ang), (float)sin((double)ang)); }
        if (i < S * 16) { const int s = i / 16, f = i % 16; const float inv = 1.0f / powf(10000.0f, (float)(2 * f) / 32.0f); const float ang = (float)s * inv;
          cs32[i] = make_float2((float)cos((double)ang), (float)sin((double)ang)); }
    }
}
__device__ __forceinline__ void p0_experts(const Frame& F, AP a, int l) {
    LAS float* scr = (LAS float*)(F.lds + F.wave * 16384);
    const int gw = F.vcu * NWAVES + F.wave, NGW = F.G * NWAVES;
    constexpr int I_GU = 16 * 16, I_D = 4 * 32, I_E = I_GU + I_D;
    const float* Wg = a->in[19] + (size_t)l * NE * D * FF; const float* Wu = a->in[20] + (size_t)l * NE * D * FF; const float* Wdn = a->in[21] + (size_t)l * NE * FF * D;
#pragma unroll 1
    for (int it = gw; it < NE * I_E; it += NGW) {
        const int e = it / I_E; int r = it % I_E;
        if (r < I_GU) { const int kb = r / 16, nb = r % 16;
            transpose_item2(Wg + (size_t)e * D * FF, nb * 16, Wu + (size_t)e * D * FF, nb * 16, FF, a->in[14] + l * D, (bf16*)(a->ws + WS_WGU) + (size_t)e * 512 * 1024, 1024, kb * 64, nb * 32, scr, F_LANE); }
        else { r -= I_GU; const int kb = r / 32, nb = r % 32; const float* W = Wdn + (size_t)e * FF * D;
            transpose_item2(W, nb * 32, W, nb * 32 + 16, D, nullptr, (bf16*)(a->ws + WS_WD) + (size_t)e * 1024 * 256, 256, kb * 64, nb * 32, scr, F_LANE); }
    }
}

__device__ __forceinline__ float reduce32(const float (&a)[32], int lane) {
    float b16[16], b8[8], b4[4], b2[2];
#pragma unroll
    for (int o = 0; o < 16; ++o) { const float send = (lane & 32) ? a[o] : a[o + 16], keep = (lane & 32) ? a[o + 16] : a[o]; b16[o] = keep + __shfl_xor(send, 32); }
#pragma unroll
    for (int o = 0; o < 8; ++o) { const float send = (lane & 16) ? b16[o] : b16[o + 8], keep = (lane & 16) ? b16[o + 8] : b16[o]; b8[o] = keep + __shfl_xor(send, 16); }
#pragma unroll
    for (int o = 0; o < 4; ++o) { const float send = (lane & 8) ? b8[o] : b8[o + 4], keep = (lane & 8) ? b8[o + 4] : b8[o]; b4[o] = keep + __shfl_xor(send, 8); }
#pragma unroll
    for (int o = 0; o < 2; ++o) { const float send = (lane & 4) ? b4[o] : b4[o + 2], keep = (lane & 4) ? b4[o + 2] : b4[o]; b2[o] = keep + __shfl_xor(send, 4); }
    const float send = (lane & 2) ? b2[0] : b2[1], keep = (lane & 2) ? b2[1] : b2[0];
    float v = keep + __shfl_xor(send, 2);
    v += __shfl_xor(v, 1);
    return v;
}

template <int MODE>
__device__ __forceinline__ void norm_pass(const Frame& F, AP a, int l) {
    const int gw = F.vcu * NWAVES + F.wave, NGW = F.G * NWAVES, lane = F_LANE;
    const float* g = (MODE == 2) ? a->in[22] : a->in[1] + l * D;
    const float* Wk = a->in[2] + (size_t)l * D * INW + 640;
    float* rr = (float*)(a->ws + WS_RA);
    bf16* xb = (bf16*)(a->ws + WS_XB);
    bf16* krope = (bf16*)(a->ws + WS_KROPE);
    float* XA = (float*)(a->ws + WS_XA);
    const bf16* ys = (const bf16*)(a->ws + WS_U);
    const float2* cs32 = (const float2*)(a->ws + WS_CS32);
#pragma unroll 1
    for (int t = gw; t < T; t += NGW) {
        const float* xr = (MODE == 0 ? a->in[0] : XA) + (size_t)t * D;
        float xv[16]; float ss = 0.f;
#pragma unroll
        for (int j = 0; j < 4; ++j) {
            float4 v = *(const float4*)(xr + j * 256 + lane * 4);
            if (MODE != 0) {
                const v2u y0 = *(const v2u*)(ys + (size_t)(2 * t) * D + j * 256 + lane * 4), y1 = *(const v2u*)(ys + (size_t)(2 * t + 1) * D + j * 256 + lane * 4);
                v.x += __uint_as_float(y0.x << 16) + __uint_as_float(y1.x << 16); v.y += __uint_as_float(y0.x & 0xffff0000u) + __uint_as_float(y1.x & 0xffff0000u);
                v.z += __uint_as_float(y0.y << 16) + __uint_as_float(y1.y << 16); v.w += __uint_as_float(y0.y & 0xffff0000u) + __uint_as_float(y1.y & 0xffff0000u);
                if (MODE == 1) *(float4*)(XA + (size_t)t * D + j * 256 + lane * 4) = v;
            }
            xv[j * 4 + 0] = v.x; xv[j * 4 + 1] = v.y; xv[j * 4 + 2] = v.z; xv[j * 4 + 3] = v.w; ss += v.x * v.x + v.y * v.y + v.z * v.z + v.w * v.w;
        }
        ss = wave_sum(ss);
        const float r = rsqrtf(ss / (float)D + EPS);
        if (MODE == 2) {
#pragma unroll
            for (int j = 0; j < 4; ++j) { const float4 gg = *(const float4*)(g + j * 256 + lane * 4);
                *(float4*)(a->out + (size_t)t * D + j * 256 + lane * 4) = make_float4(xv[j * 4 + 0] * r * gg.x, xv[j * 4 + 1] * r * gg.y, xv[j * 4 + 2] * r * gg.z, xv[j * 4 + 3] * r * gg.w); }
            continue;
        }
#pragma unroll
        for (int j = 0; j < 4; ++j) { v2u o; o.x = pk2(xv[j * 4 + 0], xv[j * 4 + 1]); o.y = pk2(xv[j * 4 + 2], xv[j * 4 + 3]); *(v2u*)(xb + (size_t)t * D + j * 256 + lane * 4) = o; }
        float acc[32];
#pragma unroll
        for (int o = 0; o < 32; ++o) acc[o] = 0.f;
#pragma unroll
        for (int j = 0; j < 4; ++j)
#pragma unroll
            for (int c = 0; c < 4; ++c) {
                const int i = j * 256 + lane * 4 + c;
                const float tv = xv[j * 4 + c] * r * g[i];
#pragma unroll
                for (int q = 0; q < 8; ++q) { float4 w = *(const float4*)(Wk + (size_t)i * INW + q * 4); acc[q * 4 + 0] += tv * w.x; acc[q * 4 + 1] += tv * w.y; acc[q * 4 + 2] += tv * w.z; acc[q * 4 + 3] += tv * w.w; }
                if (c & 1) { asm volatile("" ::: "memory"); __builtin_amdgcn_sched_barrier(0); }
            }
        const float val = reduce32(acc, lane);
        const float partner = __shfl_xor(val, 32);
        const int oo = (lane >> 1) & 31, s = t % S;
        const float2 c = cs32[s * 16 + (oo & 15)];
        const float ro = (oo < 16) ? (val * c.x - partner * c.y) : (val * c.x + partner * c.y);
        if (lane == 0) rr[t] = r;
        if ((lane & 1) == 0) krope[(size_t)t * 32 + oo] = f2bf(ro);
    }
}

struct DenseOrder {
    int nM, nN, G, c; const pg8::bf16_t* Bt; int ldb;
    __device__ __forceinline__ bool next(int i, pg8::Unit& u) const {
        const int L = i * G + c; if (L >= nM * nN) return false;
        u.pm = L / nN; u.pn = L % nN; u.e = 0; u.cnt = 256; return true;
    }
    __device__ __forceinline__ unsigned arow(const pg8::Unit& u, int r) const { return (unsigned)(u.pm * 256 + r); }
    __device__ __forceinline__ const pg8::bf16_t* bbase(const pg8::Unit& u) const { return Bt + (size_t)u.pn * 256 * ldb; }
};

struct EpiU {
    static constexpr bool PERM = false;
    bf16* O; const float* rs; float* ssq; const float2* cs32; const float2* cs64;
    __device__ __forceinline__ void operator()(const pg8::f32x4 (&acc)[2][2][4][2], const pg8::Unit& u, int wr, int wc, int fr, int fq) const {
        const int row0 = u.pm * 256 + wr * 64 + fr;
#pragma unroll
        for (int bj = 0; bj < 2; ++bj) {
            const int G32 = u.pn * 8 + bj * 4 + wc, col0 = G32 * 32 + 4 * fq;
            int kind; float qs = 1.f;
            if (G32 < 12) kind = 0; else if (G32 < 20) kind = 1; else if (G32 < 32) { kind = 2; qs = 0.125f * LOG2E; } else if (G32 < 36) kind = 3;
            else if (G32 < 40) kind = 4; else if (G32 < 48) { kind = 5; qs = 0.17677669529663687f * LOG2E; } else if (G32 < 56) kind = 6; else kind = 4;
#pragma unroll
            for (int ai = 0; ai < 2; ++ai)
#pragma unroll
                for (int m = 0; m < 4; ++m) {
                    const int row = row0 + ai * 128 + m * 16; const float sc = rs[row];
                    pg8::f32x4 v0 = acc[ai][bj][m][0] * sc, v1 = acc[ai][bj][m][1] * sc;
                    if (kind <= 1) {
                        float s = v0[0] * v0[0] + v0[1] * v0[1] + v0[2] * v0[2] + v0[3] * v0[3] + v1[0] * v1[0] + v1[1] * v1[1] + v1[2] * v1[2] + v1[3] * v1[3];
                        s += __shfl_xor(s, 16); s += __shfl_xor(s, 32);
                        if (fq == 0) ssq[(size_t)row * 20 + G32] = s;
                    } else if (kind != 4) {
                        const int spos = row % S;
                        const float2* cs = (kind == 2 || kind == 3) ? cs64 + spos * 32 + 16 * (G32 & 1) + 4 * fq : cs32 + spos * 16 + 4 * fq;
#pragma unroll
                        for (int j = 0; j < 4; ++j) { const float2 c = cs[j]; const float x1 = v0[j], x2 = v1[j]; v0[j] = (x1 * c.x - x2 * c.y) * qs; v1[j] = (x2 * c.x + x1 * c.y) * qs; }
                    }
                    bf16* rowp = O + (size_t)row * 2048 + col0;
                    v2u w0, w1; w0.x = pk2(v0[0], v0[1]); w0.y = pk2(v0[2], v0[3]); w1.x = pk2(v1[0], v1[1]); w1.y = pk2(v1[2], v1[3]);
                    *(v2u*)rowp = w0; *(v2u*)(rowp + 16) = w1;
                    asm volatile("" ::: "memory");
                }
        }
    }
};
__device__ __forceinline__ void p1_gemm(const Frame& F, AP a, int l) {
    pg8::Gemm g{(const pg8::bf16_t*)(a->ws + WS_XB), (const pg8::bf16_t*)(a->ws + WS_WSMALL + (size_t)l * WSM_LAYER + WSM_IN), 1024, 1024, 1024};
    DenseOrder S_{T / 256, 2048 / 256, F.G, F.vcu, g.Bt, 1024};
    EpiU E{(bf16*)(a->ws + WS_U), (const float*)(a->ws + WS_RA), (float*)(a->ws + WS_SSQP), (const float2*)(a->ws + WS_CS32), (const float2*)(a->ws + WS_CS64)};
    pg8::gemm_phase<EpiU, DenseOrder, true>(F.lds, g, S_, E, F.wave, F_LANE);
}

struct EpiQ {
    static constexpr bool PERM = false;
    bf16* O; const float* ssq; const float2* cs32;
    __device__ __forceinline__ void operator()(const pg8::f32x4 (&acc)[2][2][4][2], const pg8::Unit& u, int wr, int wc, int fr, int fq) const {
        const int row0 = u.pm * 256 + wr * 64 + fr; const float qs = 0.10206207261596577f * LOG2E;
#pragma unroll
        for (int bj = 0; bj < 2; ++bj) {
            const int G32 = u.pn * 8 + bj * 4 + wc, col0 = G32 * 32 + 4 * fq;
            if (G32 >= 18) continue;
            const bool rope = (G32 % 3) == 2;
#pragma unroll
            for (int ai = 0; ai < 2; ++ai)
#pragma unroll
                for (int m = 0; m < 4; ++m) {
                    const int row = row0 + ai * 128 + m * 16; const pg8::f32x4 sa = *(const pg8::f32x4*)(ssq + (size_t)row * 20), sb = *(const pg8::f32x4*)(ssq + (size_t)row * 20 + 4), sc3 = *(const pg8::f32x4*)(ssq + (size_t)row * 20 + 8);
                    const float sq = ((sa[0] + sa[1]) + (sa[2] + sa[3])) + ((sb[0] + sb[1]) + (sb[2] + sb[3])) + ((sc3[0] + sc3[1]) + (sc3[2] + sc3[3]));
                    const float sc = rsqrtf(sq * (1.0f / 384.0f) + EPS) * qs;
                    pg8::f32x4 v0 = acc[ai][bj][m][0] * sc, v1 = acc[ai][bj][m][1] * sc;
                    if (rope) { const float2* cs = cs32 + (row % S) * 16 + 4 * fq;
#pragma unroll
                        for (int j = 0; j < 4; ++j) { const float2 c = cs[j]; const float x1 = v0[j], x2 = v1[j]; v0[j] = x1 * c.x - x2 * c.y; v1[j] = x2 * c.x + x1 * c.y; } }
                    bf16* rowp = O + (size_t)row * 576 + col0;
                    v2u w0, w1; w0.x = pk2(v0[0], v0[1]); w0.y = pk2(v0[2], v0[3]); w1.x = pk2(v1[0], v1[1]); w1.y = pk2(v1[2], v1[3]);
                    *(v2u*)rowp = w0; *(v2u*)(rowp + 16) = w1;
                    asm volatile("" ::: "memory");
                }
        }
    }
};
struct EpiKV {
    static constexpr bool PERM = true;
    bf16* O; const float* ssq;
    __device__ __forceinline__ void operator()(const pg8::f32x4 (&acc)[2][2][4][2], const pg8::Unit& u, int wr, int wc, int fr, int fq) const {
        const int row0 = u.pm * 256 + wr * 64 + fr, col0 = u.pn * 256 + wc * 32 + 8 * fq;
#pragma unroll
        for (int ai = 0; ai < 2; ++ai)
#pragma unroll
            for (int m = 0; m < 4; ++m) {
                const int row = row0 + ai * 128 + m * 16; const pg8::f32x4 sa = *(const pg8::f32x4*)(ssq + (size_t)row * 20 + 12), sb = *(const pg8::f32x4*)(ssq + (size_t)row * 20 + 16);
                const float sc = rsqrtf((((sa[0] + sa[1]) + (sa[2] + sa[3])) + ((sb[0] + sb[1]) + (sb[2] + sb[3]))) * (1.0f / 256.0f) + EPS);
                bf16* rowp = O + (size_t)row * 768 + col0;
#pragma unroll
                for (int bj = 0; bj < 2; ++bj) { const pg8::f32x4 v0 = acc[ai][bj][m][0] * sc, v1 = acc[ai][bj][m][1] * sc;
                    v4u w; w.x = pk2(v0[0], v0[1]); w.y = pk2(v0[2], v0[3]); w.z = pk2(v1[0], v1[1]); w.w = pk2(v1[2], v1[3]);
                    *(v4u*)(rowp + bj * 128) = w; }
                asm volatile("" ::: "memory");
            }
    }
};
__device__ __forceinline__ void p1b_q(const Frame& F, AP a, int l) {
    const float* ssq = (const float*)(a->ws + WS_SSQP);
    unsigned char* wl = a->ws + WS_WSMALL + (size_t)l * WSM_LAYER;
    pg8::Gemm g{(const pg8::bf16_t*)(a->ws + WS_U), (const pg8::bf16_t*)(wl + WSM_UQ), 2048, 384, 384};
    DenseOrder S_{T / 256, 3, F.G, F.vcu, g.Bt, 384};
    EpiQ E{(bf16*)(a->ws + WS_QM), ssq, (const float2*)(a->ws + WS_CS32)};
    pg8::gemm_phase<EpiQ, DenseOrder, true>(F.lds, g, S_, E, F.wave, F_LANE);
}
__device__ __forceinline__ void p1b_kv(const Frame& F, AP a, int l) {
    const float* ssq = (const float*)(a->ws + WS_SSQP);
    unsigned char* wl = a->ws + WS_WSMALL + (size_t)l * WSM_LAYER;
    pg8::Gemm g{(const pg8::bf16_t*)(a->ws + WS_U) + 384, (const pg8::bf16_t*)(wl + WSM_UKV), 2048, 256, 256};
    DenseOrder S_{T / 256, 3, F.G, (F.vcu + 64) % F.G, g.Bt, 256};
    EpiKV E{(bf16*)(a->ws + WS_KVM), ssq};
    pg8::gemm_phase<EpiKV, DenseOrder, true>(F.lds, g, S_, E, F.wave, F_LANE);
}

__device__ __forceinline__ void attn_phase(const Frame& F, AP a, int l) {
    const bf16* U = (const bf16*)(a->ws + WS_U); bf16* Oc = (bf16*)(a->ws + WS_XB);
    const float lambda_init = 0.8f - 0.6f * expf(-0.3f * (float)l);
    float d1 = 0.f, d2 = 0.f;
    for (int i = 0; i < 32; ++i) { d1 += a->in[8][l * 32 + i] * a->in[9][l * 32 + i]; d2 += a->in[10][l * 32 + i] * a->in[11][l * 32 + i]; }
    const float lam = expf(d1) - expf(d2) + lambda_init;
    const int nd = NB * 32, nm = NB * 48, nsw = NB * 48;
    const int lane = F_LANE;
    {
        const att::AttnP pd{U, 2048, 1280, 64, U, 2048, 1536, 64, 1, nullptr, 0, U, 2048, 1792, 64, 1, Oc, D, 768, 64, nullptr, lam, 1.0f - lambda_init, a->in[12] + l * 64};
#pragma unroll 1
        for (int u = F.vcu; u < nd; u += F.G) att::attn_unit<2>(pd, u / 32, (u % 32) / 8, u % 8, (att::ldsp)F.lds, F.wave, lane);
    }
    {
        const att::AttnP pm{(const bf16*)(a->ws + WS_QM), 576, 0, 96, (const bf16*)(a->ws + WS_KVM), 768, 0, 128, 1, (const bf16*)(a->ws + WS_KROPE), 32, (const bf16*)(a->ws + WS_KVM), 768, 64, 128, 1, Oc, D, 0, 64, nullptr, 0.f, 0.f, nullptr};
#pragma unroll 1
        for (int u = (F.vcu + F.G - nd % F.G) % F.G; u < nm; u += F.G) att::attn_unit<0>(pm, u / 48, (u % 48) / 8, u % 8, (att::ldsp)F.lds, F.wave, lane);
    }
    {
        const att::AttnP ps{U, 2048, 640, 64, U, 2048, 1024, 64, 3, nullptr, 0, U, 2048, 1152, 64, 3, Oc, D, 384, 64, a->in[7] + l * 6, 0.f, 0.f, nullptr};
#pragma unroll 1
        for (int u = (F.vcu + 2 * F.G - (nd + nm) % F.G) % F.G; u < nsw; u += F.G) att::attn_unit<1>(ps, u / 48, (u % 48) / 8, u % 8, (att::ldsp)F.lds, F.wave, lane);
    }
}

struct EpiRes {
    static constexpr bool PERM = false;
    const float* res; float* O;
    __device__ __forceinline__ void operator()(const pg8::f32x4 (&acc)[2][2][4][2], const pg8::Unit& u, int wr, int wc, int fr, int fq) const {
        const int row0 = u.pm * 256 + wr * 64 + fr, col0 = u.pn * 256 + wc * 32 + 4 * fq;
#pragma unroll
        for (int ai = 0; ai < 2; ++ai)
#pragma unroll
            for (int m = 0; m < 4; ++m) {
                const size_t off = (size_t)(row0 + ai * 128 + m * 16) * D + col0;
#pragma unroll
                for (int bj = 0; bj < 2; ++bj)
#pragma unroll
                    for (int n = 0; n < 2; ++n) { const pg8::f32x4 r = *(const pg8::f32x4*)(res + off + bj * 128 + n * 16); *(pg8::f32x4*)(O + off + bj * 128 + n * 16) = r + acc[ai][bj][m][n]; }
                asm volatile("" ::: "memory");
            }
    }
};
__device__ __forceinline__ void p3_outproj(const Frame& F, AP a, int l) {
    pg8::Gemm g{(const pg8::bf16_t*)(a->ws + WS_XB), (const pg8::bf16_t*)(a->ws + WS_WSMALL + (size_t)l * WSM_LAYER + WSM_OUT), 1024, 1024, 1024};
    DenseOrder S_{T / 256, 4, F.G, F.vcu, g.Bt, 1024};
    EpiRes E{l == 0 ? a->in[0] : (const float*)(a->ws + WS_XA), (float*)(a->ws + WS_XA)};
    pg8::gemm_phase<EpiRes, DenseOrder, true>(F.lds, g, S_, E, F.wave, F_LANE);
}

__device__ __forceinline__ void route_pass(const Frame& F, AP a, int l) {
    const int lane = F_LANE;
    const float* g = a->in[14] + l * D; const float* Wrg = a->in[15] + (size_t)l * D * 4; const float* brg = a->in[16] + l * 4;
    const float* Wre = a->in[17] + (size_t)l * D * 32; const float* bre = a->in[18] + l * 32;
    const float* XA = (const float*)(a->ws + WS_XA);
    float* rF = (float*)(a->ws + WS_RF); bf16* xb = (bf16*)(a->ws + WS_XB);
    float* slot_w = (float*)(a->ws + WS_SLOTW); int* list = (int*)(a->ws + WS_LIST);
    int* cnt = (int*)(a->ws + WS_CTL + CTL_CNT) + l * 32;
    LAS int* hist = (LAS int*)(F.lds + LDS_MISC);
    LAS int* tokinfo = hist + 64;
    const int tpb = T / F.G;
    if (F_TID < 64) hist[F_TID] = 0;
    __syncthreads();
#pragma unroll 1
    for (int i = F.wave; i < tpb; i += NWAVES) {
        const int t = F.vcu * tpb + i;
        const float* xr = XA + (size_t)t * D;
        float xv[16]; float ss = 0.f;
#pragma unroll
        for (int j = 0; j < 4; ++j) { float4 v = *(const float4*)(xr + j * 256 + lane * 4); xv[j * 4 + 0] = v.x; xv[j * 4 + 1] = v.y; xv[j * 4 + 2] = v.z; xv[j * 4 + 3] = v.w; ss += v.x * v.x + v.y * v.y + v.z * v.z + v.w * v.w; }
        ss = wave_sum(ss);
        const float r = rsqrtf(ss / (float)D + EPS);
#pragma unroll
        for (int j = 0; j < 4; ++j) { v2u o; o.x = pk2(xv[j * 4 + 0], xv[j * 4 + 1]); o.y = pk2(xv[j * 4 + 2], xv[j * 4 + 3]); *(v2u*)(xb + (size_t)t * D + j * 256 + lane * 4) = o; }
        float acc[32], ag[4] = {0.f, 0.f, 0.f, 0.f};
#pragma unroll
        for (int o = 0; o < 32; ++o) acc[o] = 0.f;
#pragma unroll
        for (int j = 0; j < 4; ++j)
#pragma unroll
            for (int c = 0; c < 4; ++c) {
                const int ii = j * 256 + lane * 4 + c;
                const float tv = xv[j * 4 + c] * r * g[ii];
                const float4 wg = *(const float4*)(Wrg + (size_t)ii * 4);
                ag[0] += tv * wg.x; ag[1] += tv * wg.y; ag[2] += tv * wg.z; ag[3] += tv * wg.w;
#pragma unroll
                for (int q = 0; q < 8; ++q) { const float4 w = *(const float4*)(Wre + (size_t)ii * 32 + q * 4); acc[q * 4 + 0] += tv * w.x; acc[q * 4 + 1] += tv * w.y; acc[q * 4 + 2] += tv * w.z; acc[q * 4 + 3] += tv * w.w; }
                if (c & 1) { asm volatile("" ::: "memory"); __builtin_amdgcn_sched_barrier(0); }
            }
        float gl[4];
#pragma unroll
        for (int o = 0; o < 4; ++o) gl[o] = wave_sum(ag[o]) + brg[o];
        int gi = 0; float gm = gl[0];
#pragma unroll
        for (int o = 1; o < 4; ++o) if (gl[o] > gm) { gm = gl[o]; gi = o; }
        float gs = 0.f;
#pragma unroll
        for (int o = 0; o < 4; ++o) gs += expf(gl[o] - gm);
        const float ggate = 1.0f / gs;
        const int oo = (lane >> 1) & 31;
        const float ev = reduce32(acc, lane) + bre[oo];
        float ein[8];
#pragma unroll
        for (int k = 0; k < 8; ++k) ein[k] = __shfl(ev, 16 * gi + 2 * k);
        int i1 = 0; float v1 = ein[0];
#pragma unroll
        for (int k = 1; k < 8; ++k) if (ein[k] > v1) { v1 = ein[k]; i1 = k; }
        int i2 = -1; float v2 = -INFINITY;
#pragma unroll
        for (int k = 0; k < 8; ++k) if (k != i1 && ein[k] > v2) { v2 = ein[k]; i2 = k; }
        const float e2 = expf(v2 - v1);
        if (lane == 0) {
            rF[t] = r;
            slot_w[t * 2 + 0] = ggate / (1.0f + e2); slot_w[t * 2 + 1] = ggate * e2 / (1.0f + e2);
            const int ea = gi * 8 + i1, eb = gi * 8 + i2;
            tokinfo[i * 4 + 0] = ea; tokinfo[i * 4 + 1] = eb;
            tokinfo[i * 4 + 2] = __hip_atomic_fetch_add(hist + ea, 1, __ATOMIC_RELAXED, __HIP_MEMORY_SCOPE_WORKGROUP); tokinfo[i * 4 + 3] = __hip_atomic_fetch_add(hist + eb, 1, __ATOMIC_RELAXED, __HIP_MEMORY_SCOPE_WORKGROUP);
        }
    }
    __syncthreads();
    if (F_TID < 32) { const int c = hist[F_TID]; hist[32 + F_TID] = c ? atomicAdd(cnt + F_TID, c) : 0; }
    __syncthreads();
    if (F_TID < tpb * 2) {
        const int i = F_TID >> 1, k = F_TID & 1, e = tokinfo[i * 4 + k], rank = tokinfo[i * 4 + 2 + k];
        list[(size_t)e * LCAP + hist[32 + e] + rank] = (F.vcu * tpb + i) * 2 + k;
    }
    __syncthreads();
}

struct MoeOrder {
    int nN, G, c; const LAS int* tstart; const int* cnt; const int* list; const pg8::bf16_t* Bt; int ldb; size_t estride; int shift;
    __device__ __forceinline__ bool next(int i, pg8::Unit& u) const {
        const int L = i * G + c, tau = L / nN; if (tau >= tstart[32]) return false;
        int e = 0;
#pragma unroll 1
        for (int k = 16; k >= 1; k >>= 1) if (tstart[e + k] <= tau) e += k;
        u.e = e; u.pm = tau - tstart[e]; u.pn = L % nN; u.cnt = cnt[e] - u.pm * 256; return true;
    }
    __device__ __forceinline__ unsigned arow(const pg8::Unit& u, int r) const { const int rr = r < u.cnt ? r : 0; return (unsigned)(list[(size_t)u.e * LCAP + u.pm * 256 + rr] >> shift); }
    __device__ __forceinline__ const pg8::bf16_t* bbase(const pg8::Unit& u) const { return Bt + (size_t)u.e * estride + (size_t)u.pn * 256 * ldb; }
};
struct EpiGU {
    static constexpr bool PERM = false;
    bf16* hid; const float* rF; const float* slot_w; const int* list;
    __device__ __forceinline__ void operator()(const pg8::f32x4 (&acc)[2][2][4][2], const pg8::Unit& u, int wr, int wc, int fr, int fq) const {
        const int* lp = list + (size_t)u.e * LCAP + u.pm * 256;
#pragma unroll
        for (int ai = 0; ai < 2; ++ai)
#pragma unroll
            for (int m = 0; m < 4; ++m) {
                const int r = ai * 128 + wr * 64 + m * 16 + fr;
                if (r < u.cnt) {
                    const int slot = lp[r]; const float rf = rF[slot >> 1], w = slot_w[slot];
                    bf16* rowp = hid + (size_t)slot * 256 + u.pn * 128 + wc * 16 + 4 * fq;
#pragma unroll
                    for (int bj = 0; bj < 2; ++bj) {
                        float h[4];
#pragma unroll
                        for (int j = 0; j < 4; ++j) { const float av = acc[ai][bj][m][0][j] * rf, uv = acc[ai][bj][m][1][j] * rf; h[j] = av / (1.0f + __expf(-av)) * uv * w; }
                        v2u o; o.x = pk2(h[0], h[1]); o.y = pk2(h[2], h[3]); *(v2u*)(rowp + bj * 64) = o;
                    }
                }
                asm volatile("" ::: "memory");
            }
    }
};
struct EpiDown {
    static constexpr bool PERM = true;
    bf16* y; const int* list;
    __device__ __forceinline__ void operator()(const pg8::f32x4 (&acc)[2][2][4][2], const pg8::Unit& u, int wr, int wc, int fr, int fq) const {
        const int* lp = list + (size_t)u.e * LCAP + u.pm * 256; const int col0 = u.pn * 256 + wc * 32 + 8 * fq;
#pragma unroll
        for (int ai = 0; ai < 2; ++ai)
#pragma unroll
            for (int m = 0; m < 4; ++m) {
                const int r = ai * 128 + wr * 64 + m * 16 + fr;
                if (r < u.cnt) {
                    bf16* rowp = y + (size_t)lp[r] * D + col0;
#pragma unroll
                    for (int bj = 0; bj < 2; ++bj) { const pg8::f32x4 v0 = acc[ai][bj][m][0], v1 = acc[ai][bj][m][1];
                        v4u w; w.x = pk2(v0[0], v0[1]); w.y = pk2(v0[2], v0[3]); w.z = pk2(v1[0], v1[1]); w.w = pk2(v1[2], v1[3]);
                        *(v4u*)(rowp + bj * 128) = w; }
                }
                asm volatile("" ::: "memory");
            }
    }
};
__device__ __forceinline__ void moe_tiles(const Frame& F, const int* cnt) {
    LAS int* tstart = (LAS int*)(F.lds + LDS_MISC);
    if (F_TID == 0) { int acc = 0; for (int e = 0; e < 32; ++e) { tstart[e] = acc; acc += (cnt[e] + 255) >> 8; } tstart[32] = acc; }
    __syncthreads();
}
__device__ __forceinline__ void moe_gateup(const Frame& F, AP a, int l) {
    const int* cnt = (const int*)(a->ws + WS_CTL + CTL_CNT) + l * 32; const int* list = (const int*)(a->ws + WS_LIST);
    moe_tiles(F, cnt);
    pg8::Gemm g{(const pg8::bf16_t*)(a->ws + WS_XB), (const pg8::bf16_t*)(a->ws + WS_WGU), 1024, 1024, 1024};
    MoeOrder S_{2, F.G, F.vcu, (const LAS int*)(F.lds + LDS_MISC), cnt, list, g.Bt, 1024, (size_t)512 * 1024, 1};
    EpiGU E{(bf16*)(a->ws + WS_QM), (const float*)(a->ws + WS_RF), (const float*)(a->ws + WS_SLOTW), list};
    pg8::gemm_phase<EpiGU, MoeOrder, true>(F.lds, g, S_, E, F.wave, F_LANE);
}
__device__ __forceinline__ void moe_down(const Frame& F, AP a, int l) {
    const int* cnt = (const int*)(a->ws + WS_CTL + CTL_CNT) + l * 32; const int* list = (const int*)(a->ws + WS_LIST);
    moe_tiles(F, cnt);
    pg8::Gemm g{(const pg8::bf16_t*)(a->ws + WS_QM), (const pg8::bf16_t*)(a->ws + WS_WD), 256, 256, 256};
    MoeOrder S_{4, F.G, F.vcu, (const LAS int*)(F.lds + LDS_MISC), cnt, list, g.Bt, 256, (size_t)1024 * 256, 0};
    EpiDown E{(bf16*)(a->ws + WS_U), list};
    pg8::gemm_phase<EpiDown, MoeOrder, true>(F.lds, g, S_, E, F.wave, F_LANE);
}

__device__ __forceinline__ void run_phase(const Frame& F, AP ap, int ph, int l) {
    AP args = launder(ap);
    switch (ph) {
        case 0: p0_small(F, args); break;
        case 1: p0_experts(F, args, l); break;
        case 2: norm_pass<0>(F, args, l); break;
        case 3: p1_gemm(F, args, l); break;
        case 4: p1b_q(F, args, l); break;
        case 12: p1b_kv(F, args, l); break;
        case 5: attn_phase(F, args, l); break;
        case 6: p3_outproj(F, args, l); break;
        case 7: route_pass(F, args, l); break;
        case 8: moe_gateup(F, args, l); break;
        case 9: moe_down(F, args, l); break;
        case 10: norm_pass<1>(F, args, l); break;
        case 11: norm_pass<2>(F, args, l); break;
        default: break;
    }
}
__global__ void __launch_bounds__(NWAVES * 64, 2) mega(Args args_unused) {
    extern __shared__ __attribute__((aligned(16))) unsigned char lds[];
    AP ap = (AP)__builtin_amdgcn_kernarg_segment_ptr();
    Frame F;
    F.lds = (LAS unsigned char*)lds;
    F.wave = __builtin_amdgcn_readfirstlane((int)threadIdx.x >> 6);
    F.G = gridDim.x; { const int bx = blockIdx.x; F.vcu = (F.G % 8 == 0) ? (bx % 8) * (F.G / 8) + bx / 8 : bx; }
    run_phase(F, ap, ap->phase, ap->layer);
}
extern "C" void kernel_launch(void* const* d_in, const int* in_sizes, int n_in, void* d_out, int out_size, void* d_ws, size_t ws_size, hipStream_t stream) {
    static int grid = 0;
    if (grid == 0) {
        int dev = 0, cus = 0;
        hipGetDevice(&dev); hipDeviceGetAttribute(&cus, hipDeviceAttributeMultiprocessorCount, dev);
        (void)hipFuncSetAttribute((const void*)mega, hipFuncAttributeMaxDynamicSharedMemorySize, LDS_BYTES);
        if (n_in != 23 || ws_size < WS_END || cus < 256) { fprintf(stderr, "kernel_launch: unexpected configuration (n_in %d, ws %zu, CUs %d)\n", n_in, ws_size, cus); grid = -1; return; }
        grid = 256;
    }
    if (grid < 0) return;
    (void)hipMemsetAsync((char*)d_ws + WS_CTL, 0, 1 * MiB, stream);
    Args a{};
    for (int i = 0; i < 23; ++i) a.in[i] = (const float*)d_in[i];
    a.out = (float*)d_out; a.ws = (unsigned char*)d_ws;
    auto launch = [&](int ph, int l) { a.phase = ph; a.layer = l; hipLaunchKernelGGL(mega, dim3(grid), dim3(NWAVES * 64), LDS_BYTES, stream, a); };
    launch(0, 0); launch(1, 0); launch(2, 0);
    for (int l = 0; l < NL; ++l) {
        launch(3, l); launch(4, l); launch(12, l); launch(5, l); launch(6, l); launch(7, l); launch(8, l); launch(9, l);
        if (l == 0) { launch(1, 1); launch(10, 1); } else launch(11, 0);
    }
}
```

```cpp
#include <hip/hip_runtime.h>
#include <math.h>
#include <stdint.h>
#include <cstdio>
#include <hip/hip_cooperative_groups.h>
constexpr int D = 1024, NB = 8, S = 2048, T = NB * S, INW = 2080, NL = 2;
constexpr int NE = 32, FF = 256;
constexpr float EPS = 1e-6f;

__device__ __forceinline__ float wave_sum(float v) {
#pragma unroll
    for (int o = 32; o >= 1; o >>= 1) v += __shfl_xor(v, o);
    return v;
}
__device__ __forceinline__ float wave_max(float v) {
#pragma unroll
    for (int o = 32; o >= 1; o >>= 1) v = fmaxf(v, __shfl_xor(v, o));
    return v;
}
namespace pg8 {
#define PG8_LAS __attribute__((address_space(3)))
typedef unsigned short bf16_t;
typedef short bf16x8 __attribute__((ext_vector_type(8)));
typedef float f32x4 __attribute__((ext_vector_type(4)));
typedef unsigned u32x4 __attribute__((ext_vector_type(4)));
typedef unsigned u32x2 __attribute__((ext_vector_type(2)));
constexpr int BM = 256, BK = 64, HALF = 128, HTB = HALF * BK * 2  , STAGE_BYTES = 8 * HTB;

__device__ __forceinline__ int lds_byte(int r, int c) { const int st = (r >> 4) * 2 + (c >> 5), rr = r & 15, cc = c & 31, ob = rr * 64 + cc * 2; return st * 1024 + (ob ^ (((ob >> 9) & 1) << 5)); }
__device__ __forceinline__ void stage_rc(int b, int& R, int& C) { const int st = b / 1024, sb = b % 1024, swz = sb ^ (((sb >> 9) & 1) << 5); R = (st >> 1) * 16 + swz / 64; C = (st & 1) * 32 + (swz % 64) / 2; }
__device__ __forceinline__ int perm32(int rho) { const int n = rho >> 4, i = rho & 15; return 8 * (i >> 2) + 4 * n + (i & 3); }

struct Unit { int pm, pn, e, cnt, tau; };
struct Gemm { const bf16_t* A; const bf16_t* Bt; int lda, ldb, K; };

__device__ __forceinline__ unsigned cvt_pk_bf16(float lo, float hi) {
    typedef float f2 __attribute__((ext_vector_type(2))); typedef __bf16 b2 __attribute__((ext_vector_type(2)));
    f2 v = {lo, hi}; b2 b = __builtin_convertvector(v, b2); return __builtin_bit_cast(unsigned, b);
}

__device__ __forceinline__ void stage2(PG8_LAS unsigned char* lds, int bufoff, unsigned ldsw, const char* gbase, const unsigned (&voff)[2], size_t kb) {
#pragma unroll
    for (int i = 0; i < 2; ++i)
        __builtin_amdgcn_global_load_lds((const unsigned*)(gbase + voff[i] + kb), (PG8_LAS unsigned*)(lds + bufoff + ldsw + i * 8192), 16, 0, 0);
}

template <class Epi, class Sched, bool ALIGN_EPI>
__device__ __forceinline__ void gemm_phase(PG8_LAS unsigned char* lds, const Gemm g, const Sched& S, const Epi& E, const int wid, const int lane) {
    const int tid = wid * 64 + lane, wr = wid >> 2, wc = wid & 3, fr = lane & 15, fq = lane >> 4;
    const int K = g.K, nt = K / BK;
    unsigned voffB[2];
#pragma unroll
    for (int i = 0; i < 2; ++i) { int R, C; stage_rc(tid * 16 + i * 8192, R, C); const int Rb = Epi::PERM ? ((R & ~31) + perm32(R & 31)) : R;
        voffB[i] = (unsigned)(Rb * g.ldb + C) * 2u; }
    const size_t kstep = (size_t)(BK * 2);
    const size_t hstepB = (size_t)HALF * g.ldb * 2;
    const unsigned ldsw = (unsigned)wid * 1024u;
    const int aoff = lds_byte(wr * 64 + fr, fq * 8), boff = lds_byte(wc * 32 + fr, fq * 8);
    const char* Ab = (const char*)g.A;
#define PG8_SA(b, h) (((b) * 2 + (h)) * HTB)
#define PG8_SB(b, h) ((4 + (b) * 2 + (h)) * HTB)
#define PG8_STAGE(bufoff, gbase, voff, kb) stage2(lds, (bufoff), ldsw, (gbase), (voff), (kb))
#define PG8_LDA(dst, b, h) do { _Pragma("unroll") for (int m = 0; m < 4; ++m) _Pragma("unroll") for (int k = 0; k < 2; ++k) dst[m][k] = *(const PG8_LAS bf16x8*)(lds + PG8_SA(b, h) + aoff + m * 2048 + k * 1024); } while (0)
#define PG8_LDB(dst, b, h) do { _Pragma("unroll") for (int n = 0; n < 2; ++n) _Pragma("unroll") for (int k = 0; k < 2; ++k) dst[n][k] = *(const PG8_LAS bf16x8*)(lds + PG8_SB(b, h) + boff + n * 2048 + k * 1024); } while (0)
#define PG8_MMA(ai, bj, At, Bt) do { __builtin_amdgcn_s_setprio(1); _Pragma("unroll") for (int m = 0; m < 4; ++m) _Pragma("unroll") for (int n = 0; n < 2; ++n) _Pragma("unroll") for (int k = 0; k < 2; ++k) \
        acc[ai][bj][m][n] = __builtin_amdgcn_mfma_f32_16x16x32_bf16(Bt[n][k], At[m][k], acc[ai][bj][m][n], 0, 0, 0); __builtin_amdgcn_s_setprio(0); } while (0)
#define PG8_WAIT_V(n) asm volatile("s_waitcnt vmcnt(" #n ")" ::: "memory")
#define PG8_WAIT_L(n) asm volatile("s_waitcnt lgkmcnt(" #n ")" ::: "memory")
#define PG8_BAR __builtin_amdgcn_s_barrier()
#define PG8_SCHED __builtin_amdgcn_sched_barrier(0)
#define PG8_MKOFF(u, d0, d1) do { _Pragma("unroll") for (int _i = 0; _i < 2; ++_i) { int _R, _C; stage_rc(tid * 16 + _i * 8192, _R, _C); d0[_i] = (S.arow(u, _R) * (unsigned)g.lda + (unsigned)_C) * 2u; d1[_i] = (S.arow(u, HALF + _R) * (unsigned)g.lda + (unsigned)_C) * 2u; } } while (0)
    Unit cur, nxt; int ui = 0;
    if (!S.next(0, cur)) return;
    f32x4 acc[2][2][4][2];
#pragma unroll
    for (int a = 0; a < 2; ++a)
#pragma unroll
        for (int b = 0; b < 2; ++b)
#pragma unroll
            for (int m = 0; m < 4; ++m)
#pragma unroll
                for (int n = 0; n < 2; ++n) acc[a][b][m][n] = (f32x4){0.f, 0.f, 0.f, 0.f};
    bf16x8 At[4][2], B0[2][2], B1[2][2];
    unsigned o0[2], o1[2], n0[2], n1[2];
    PG8_MKOFF(cur, o0, o1);
    const char* cB = (const char*)S.bbase(cur);
    PG8_STAGE(PG8_SB(0, 0), cB, voffB, 0); PG8_STAGE(PG8_SB(0, 1), cB + hstepB, voffB, 0); PG8_STAGE(PG8_SA(0, 0), Ab, o0, 0); PG8_STAGE(PG8_SA(0, 1), Ab, o1, 0);
    if (wr == 1) PG8_BAR;
    PG8_WAIT_V(2); PG8_BAR;
    PG8_STAGE(PG8_SB(1, 0), cB, voffB, kstep); PG8_STAGE(PG8_SA(1, 0), Ab, o0, kstep); PG8_STAGE(PG8_SB(1, 1), cB + hstepB, voffB, kstep);
    PG8_WAIT_V(6); PG8_BAR;
    for (;;) {
        const bool has_next = S.next(ui + 1, nxt);
        const char* nB = cB;
        if (has_next) { PG8_MKOFF(nxt, n0, n1); nB = (const char*)S.bbase(nxt); }
        else {
#pragma unroll
            for (int i = 0; i < 2; ++i) { n0[i] = o0[i]; n1[i] = o1[i]; } }
#pragma unroll 1
        for (int t = 0; t < nt; t += 2) {
            const bool last = (t == nt - 2);
            const size_t a1k = (size_t)(t + 1) * kstep;
            unsigned x0[2], x1[2];
#pragma unroll
            for (int i = 0; i < 2; ++i) { x0[i] = last ? n0[i] : o0[i]; x1[i] = last ? n1[i] : o1[i]; }
            const size_t k2 = last ? 0 : (size_t)(t + 2) * kstep, k3 = k2 + kstep;
            const char* b2 = last ? nB : cB;
            PG8_LDB(B0, 0, 0); PG8_LDB(B1, 0, 1); PG8_SCHED; PG8_LDA(At, 0, 0); PG8_STAGE(PG8_SA(1, 1), Ab, o1, a1k);
            PG8_WAIT_V(8); PG8_WAIT_L(0); PG8_BAR; PG8_MMA(0, 0, At, B0); PG8_MMA(0, 1, At, B1); PG8_BAR; PG8_SCHED;
            PG8_LDA(At, 0, 1); PG8_STAGE(PG8_SB(0, 0), b2, voffB, k2); PG8_STAGE(PG8_SB(0, 1), b2 + hstepB, voffB, k2); PG8_STAGE(PG8_SA(0, 0), Ab, x0, k2);
            PG8_WAIT_V(8); PG8_WAIT_L(0); PG8_BAR; PG8_MMA(1, 0, At, B0); PG8_MMA(1, 1, At, B1); PG8_BAR; PG8_SCHED;
            PG8_LDB(B0, 1, 0); PG8_LDB(B1, 1, 1); PG8_SCHED; PG8_LDA(At, 1, 0); PG8_STAGE(PG8_SA(0, 1), Ab, x1, k2);
            PG8_WAIT_V(8); PG8_WAIT_L(0); PG8_BAR; PG8_MMA(0, 0, At, B0); PG8_MMA(0, 1, At, B1); PG8_BAR; PG8_SCHED;
            PG8_LDA(At, 1, 1); PG8_STAGE(PG8_SB(1, 0), b2, voffB, k3); PG8_STAGE(PG8_SB(1, 1), b2 + hstepB, voffB, k3); PG8_STAGE(PG8_SA(1, 0), Ab, x0, k3);
            PG8_WAIT_V(8); PG8_WAIT_L(0); PG8_BAR; PG8_MMA(1, 0, At, B0); PG8_MMA(1, 1, At, B1); PG8_BAR; PG8_SCHED;
        }
        if constexpr (ALIGN_EPI) { if (wr == 0) PG8_BAR; }
        E(acc, cur, wr, wc, fr, fq);
        if (!has_next) break;
#pragma unroll
        for (int a = 0; a < 2; ++a)
#pragma unroll
            for (int b = 0; b < 2; ++b)
#pragma unroll
                for (int m = 0; m < 4; ++m)
#pragma unroll
                    for (int n = 0; n < 2; ++n) acc[a][b][m][n] = (f32x4){0.f, 0.f, 0.f, 0.f};
        cur = nxt; cB = nB; ++ui;
#pragma unroll
        for (int i = 0; i < 2; ++i) { o0[i] = n0[i]; o1[i] = n1[i]; }
        if constexpr (ALIGN_EPI) { if (wr == 1) PG8_BAR; }
    }
    PG8_WAIT_V(0);
    if constexpr (!ALIGN_EPI) { if (wr == 0) PG8_BAR; }
    PG8_BAR;
#undef PG8_SA
#undef PG8_SB
#undef PG8_STAGE
#undef PG8_LDA
#undef PG8_LDB
#undef PG8_MMA
#undef PG8_WAIT_V
#undef PG8_WAIT_L
#undef PG8_BAR
#undef PG8_SCHED
#undef PG8_MKOFF
}
}
namespace att {
typedef short bf16x8 __attribute__((ext_vector_type(8)));
typedef short s16x4 __attribute__((ext_vector_type(4)));
typedef float f32x16 __attribute__((ext_vector_type(16)));
typedef __attribute__((address_space(3))) unsigned char* ldsp;
constexpr int KSLOT = 12288, VSLOT = 8192, K_OFF = 0, V_OFF = 2 * KSLOT, WS_OFF = V_OFF + 2 * VSLOT, OST_OFF = 65536  , ATT_LDS = OST_OFF + 8 * 4096;
constexpr float LOG2E = 1.4426950408889634f;
constexpr float THR = 8.0f;

struct AttnP {
    const unsigned short* Q; int qp, qc, qhs;
    const unsigned short* K; int kp, kc, khs, kgrp;
    const unsigned short* K2; int k2p;
    const unsigned short* V; int vp, vc, vhs, vgrp;
    unsigned short* O; int op, oc, ohs;
    const float* sink;
    float lam, omli; const float* subln;
    unsigned* done;
};

__device__ __forceinline__ int crow(int r, int hi) { return (r & 3) + 8 * (r >> 2) + 4 * hi; }
__device__ __forceinline__ s16x4 vtr(const __attribute__((address_space(3))) unsigned char* p) {
    typedef short v4i16_t __attribute__((ext_vector_type(4)));
    return __builtin_bit_cast(s16x4, __builtin_amdgcn_ds_read_tr16_b64_v4i16((__attribute__((address_space(3))) v4i16_t*)p));
}
__device__ __forceinline__ float max3f(float a, float b, float c) { float r; asm("v_max3_f32 %0, %1, %2, %3" : "=v"(r) : "v"(a), "v"(b), "v"(c)); return r; }
__device__ __forceinline__ float max2f(float a, float b) { float r; asm("v_max_f32_e32 %0, %1, %2" : "=v"(r) : "v"(a), "v"(b)); return r; }
#define ATT_WAIT_BAR() asm volatile("s_waitcnt vmcnt(0) lgkmcnt(0)\n\ts_barrier" ::: "memory")
__device__ __forceinline__ void dma16(const void* g, unsigned lds_addr) {
    asm volatile("s_mov_b32 m0, %1\n\ts_nop 0\n\tglobal_load_lds_dwordx4 %0, off" :: "v"(g), "s"(lds_addr) : "memory", "m0");
}

template <int MIX>
__device__ __forceinline__ void attn_unit(const AttnP& P, int b, int h, int qb, ldsp lds, int wid, int lane) {
    constexpr int NC = (MIX == 2) ? 2 : 1;
    constexpr int ND = (MIX == 0) ? 6 : (MIX == 1) ? 4 : 2;
    constexpr int NKP = (MIX == 0) ? 12 : 8;
    const int r32 = lane & 31, hi = lane >> 5;
    const int q0 = qb * 256;
    const size_t rowb = (size_t)b * S;
    int kt0 = 0, nt = S / 64;
    if (MIX == 1) { const int klo = max(0, q0 - 128), khi = min(S, q0 + 256 + 128); kt0 = klo / 64; nt = (khi - klo) / 64; }
    bf16x8 qf[NC][ND];
    {
        const unsigned short* qrow = P.Q + (rowb + q0 + wid * 32 + r32) * P.qp + P.qc + h * P.qhs + hi * 8;
#pragma unroll
        for (int c = 0; c < NC; ++c)
#pragma unroll
            for (int d0 = 0; d0 < ND; ++d0) qf[c][d0] = *(const bf16x8*)(qrow + c * (ND * 16) + d0 * 16);
    }
    const unsigned short* Kb = P.K + rowb * P.kp + P.kc + (h / P.kgrp) * P.khs;
    const unsigned short* K2b = (MIX == 0) ? P.K2 + rowb * P.k2p : nullptr;
    const unsigned short* Vb = P.V + rowb * P.vp + P.vc + (h / P.vgrp) * P.vhs;
    __attribute__((address_space(3))) float* wsf = (__attribute__((address_space(3))) float*)(lds + WS_OFF) + wid * 256;
    constexpr bool NEGM = (MIX != 2);
    float mhat[NC], lsum[NC]; f32x16 o[NC][2], negm[NEGM ? NC : 1];
#pragma unroll
    for (int c = 0; c < NC; ++c) {
        mhat[c] = 0.f; lsum[c] = 0.f;
        if (MIX == 1) { mhat[c] = P.sink[h] * LOG2E; lsum[c] = (hi == 0) ? 1.f : 0.f; }
#pragma unroll
        for (int r = 0; r < 16; ++r) { o[c][0][r] = 0.f; o[c][1][r] = 0.f; if (NEGM) negm[c][r] = -mhat[c]; }
    }
    const unsigned short* psrc[3]; unsigned pstep[3], pdst[3], pslot[3];
#pragma unroll
    for (int pp = 0; pp < 3; ++pp) {
        const int p = wid + pp * 8;
        psrc[pp] = nullptr; pstep[pp] = 0; pdst[pp] = 0; pslot[pp] = 0;
        if (p < NKP + 8) {
            if (p < NKP) {
                if (MIX == 0 && p >= 8) { psrc[pp] = K2b + ((size_t)kt0 * 64 + lane) * P.k2p + (p - 8) * 8; pstep[pp] = 64u * (unsigned)P.k2p * 2u; }
                else { psrc[pp] = Kb + ((size_t)kt0 * 64 + lane) * P.kp + p * 8; pstep[pp] = 64u * (unsigned)P.kp * 2u; }
                pdst[pp] = K_OFF + p * 1024; pslot[pp] = KSLOT;
            } else {
                const int pv = p - NKP, d0 = pv >> 2, ks = pv & 3;
                psrc[pp] = Vb + ((size_t)kt0 * 64 + 16 * ks + (lane >> 2)) * P.vp + d0 * 32 + (lane & 3) * 8; pstep[pp] = 64u * (unsigned)P.vp * 2u;
                pdst[pp] = V_OFF + pv * 1024; pslot[pp] = VSLOT;
            }
        }
    }
    auto issue = [&](int j, int slot) {
#pragma unroll
        for (int pp = 0; pp < 3; ++pp) {
            if (pp < 2 || wid + 16 < NKP + 8)
                dma16((const char*)psrc[pp] + (size_t)j * pstep[pp], (unsigned)__builtin_amdgcn_readfirstlane((int)(unsigned)(size_t)(lds + pdst[pp] + slot * pslot[pp])));
        }
    };
    auto compute = [&](int j, int slot, bool first) {
        if (MIX == 1) { const int kb = (kt0 + j) * 64, qw = q0 + wid * 32; if (kb > qw + 31 + 128 || kb + 63 < qw - 128) return; }
        int ln = lane; asm volatile("" : "+v"(ln));
        const int voff = (4 * (ln >> 5) + ((ln & 15) >> 2)) * 64 + ((ln >> 4) & 1) * 32 + (ln & 3) * 8;
        const ldsp Ks = lds + K_OFF + slot * KSLOT, Vs = lds + V_OFF + slot * VSLOT;
        bf16x8 pw[NC][4];
        bf16x8 kf[NC][ND][2];
#pragma unroll
        for (int c = 0; c < NC; ++c)
#pragma unroll
            for (int d0 = 0; d0 < ND; ++d0) {
                kf[c][d0][0] = *(const __attribute__((address_space(3))) bf16x8*)(Ks + (c * 2 * ND + 2 * d0 + (ln >> 5)) * 1024 + (ln & 31) * 16);
                kf[c][d0][1] = *(const __attribute__((address_space(3))) bf16x8*)(Ks + (c * 2 * ND + 2 * d0 + (ln >> 5)) * 1024 + 512 + (ln & 31) * 16);
            }
        __builtin_amdgcn_sched_barrier(0);
        s16x4 vlo[2][4], vhi[2][4];
#pragma unroll
        for (int c = 0; c < NC; ++c) {
            f32x16 p0, p1;
            if (NEGM) { p0 = negm[c]; p1 = negm[c]; }
            else { const float nm_ = -mhat[c];
#pragma unroll
                for (int r = 0; r < 16; ++r) { p0[r] = nm_; p1[r] = nm_; } }
#pragma unroll
            for (int d0 = 0; d0 < ND; ++d0) {
                p0 = __builtin_amdgcn_mfma_f32_32x32x16_bf16(kf[c][d0][0], qf[c][d0], p0, 0, 0, 0);
                p1 = __builtin_amdgcn_mfma_f32_32x32x16_bf16(kf[c][d0][1], qf[c][d0], p1, 0, 0, 0);
            }
            if (MIX != 2 && c == NC - 1) {
#pragma unroll
                for (int d0v = 0; d0v < 2; ++d0v)
#pragma unroll
                    for (int ks = 0; ks < 4; ++ks) { vlo[d0v][ks] = vtr(Vs + d0v * 4096 + ks * 1024 + voff); vhi[d0v][ks] = vtr(Vs + d0v * 4096 + ks * 1024 + 512 + voff); }
                __builtin_amdgcn_sched_barrier(0);
            }
            if (MIX == 1 && (((kt0 + j) * 64 < q0 + wid * 32 + 31 - 128) || ((kt0 + j) * 64 + 63 > q0 + wid * 32 + 128))) {
                const int q = q0 + wid * 32 + r32, kb = (kt0 + j) * 64;
#pragma unroll
                for (int r = 0; r < 16; ++r) { const int k0 = kb + crow(r, hi), k1 = k0 + 32;
                    if (k0 < q - 128 || k0 > q + 128) p0[r] = -INFINITY;
                    if (k1 < q - 128 || k1 > q + 128) p1[r] = -INFINITY; }
            }
            asm volatile("s_nop 15\n\ts_nop 7" : "+v"(p0), "+v"(p1));
            float rm;
            {
                float ma = max3f(p0[0], p0[1], p1[0]), mb = max3f(p0[2], p0[3], p1[1]), mc = max3f(p0[4], p0[5], p1[2]), md = max3f(p0[6], p0[7], p1[3]);
                ma = max3f(ma, p1[4], p1[5]); mb = max3f(mb, p1[6], p1[7]);
#pragma unroll
                for (int r = 8; r < 16; r += 4) { ma = max3f(ma, p0[r], p0[r + 1]); mb = max3f(mb, p0[r + 2], p0[r + 3]); mc = max3f(mc, p1[r], p1[r + 1]); md = max3f(md, p1[r + 2], p1[r + 3]); }
                rm = max2f(max2f(ma, mb), max2f(mc, md));
                unsigned ru = __float_as_uint(rm); asm volatile("s_nop 1" : "+v"(ru));
                const auto rr2 = __builtin_amdgcn_permlane32_swap(ru, ru, false, false);
                rm = max2f(__uint_as_float(rr2[0]), __uint_as_float(rr2[1]));
            }
            const bool trig = first || __any(rm > THR);
            if (trig) {
                const float dl = first ? rm : fmaxf(rm, 0.f);
                mhat[c] += dl;
#pragma unroll
                for (int r = 0; r < 16; ++r) { p0[r] -= dl; p1[r] -= dl; if (NEGM) negm[c][r] = -mhat[c]; }
                if (!first) {
                    const float f = __builtin_amdgcn_exp2f(-dl);
                    lsum[c] *= f;
                    if (hi == 0) wsf[r32] = f;
                    asm volatile("s_waitcnt lgkmcnt(0)" ::: "memory");
#pragma unroll
                    for (int r = 0; r < 16; ++r) { const float fr_ = wsf[crow(r, hi)]; o[c][0][r] *= fr_; o[c][1][r] *= fr_; }
                    asm volatile("s_waitcnt lgkmcnt(0)" ::: "memory");
                }
            }
            float sa4[4] = {0.f, 0.f, 0.f, 0.f};
#pragma unroll
            for (int r = 0; r < 16; ++r) { p0[r] = __builtin_amdgcn_exp2f(p0[r]); p1[r] = __builtin_amdgcn_exp2f(p1[r]); sa4[r & 3] += p0[r] + p1[r]; }
            lsum[c] += (sa4[0] + sa4[1]) + (sa4[2] + sa4[3]);
            {
                unsigned w[16];
#pragma unroll
                for (int i = 0; i < 8; ++i) { w[i] = pg8::cvt_pk_bf16(p0[2 * i], p0[2 * i + 1]); w[8 + i] = pg8::cvt_pk_bf16(p1[2 * i], p1[2 * i + 1]); }
#pragma unroll
                for (int ks = 0; ks < 4; ++ks) { pg8::u32x4 t = {w[4 * ks], w[4 * ks + 1], w[4 * ks + 2], w[4 * ks + 3]}; pw[c][ks] = __builtin_bit_cast(bf16x8, t); }
            }
        }
#pragma unroll
        for (int d0v = 0; d0v < 2; ++d0v) {
            if (MIX == 2) {
#pragma unroll
                for (int ks = 0; ks < 4; ++ks) { vlo[d0v][ks] = vtr(Vs + d0v * 4096 + ks * 1024 + voff); vhi[d0v][ks] = vtr(Vs + d0v * 4096 + ks * 1024 + 512 + voff); }
                __builtin_amdgcn_sched_barrier(0);
            }
#pragma unroll
            for (int ks = 0; ks < 4; ++ks) {
                const bf16x8 vf = {vlo[d0v][ks][0], vlo[d0v][ks][1], vlo[d0v][ks][2], vlo[d0v][ks][3], vhi[d0v][ks][0], vhi[d0v][ks][1], vhi[d0v][ks][2], vhi[d0v][ks][3]};
#pragma unroll
                for (int c = 0; c < NC; ++c) o[c][d0v] = __builtin_amdgcn_mfma_f32_32x32x16_bf16(pw[c][ks], vf, o[c][d0v], 0, 0, 0);
            }
        }
    };
    issue(0, 0);
    ATT_WAIT_BAR();
    if (nt > 1) issue(1, 1);
    compute(0, 0, MIX != 1);
    ATT_WAIT_BAR();
#pragma unroll 1
    for (int j = 1; j < nt; ++j) {
        if (j + 1 < nt) issue(j + 1, (j + 1) & 1);
        compute(j, j & 1, false);
        ATT_WAIT_BAR();
    }
    float rl[NC][16];
#pragma unroll
    for (int c = 0; c < NC; ++c) {
        const float lt = lsum[c] + __shfl_xor(lsum[c], 32);
        if (hi == 0) wsf[32 + c * 32 + r32] = lt;
    }
    asm volatile("s_waitcnt lgkmcnt(0)" ::: "memory");
#pragma unroll
    for (int c = 0; c < NC; ++c)
#pragma unroll
        for (int r = 0; r < 16; ++r) rl[c][r] = 1.0f / wsf[32 + c * 32 + crow(r, hi)];
    asm volatile("s_waitcnt lgkmcnt(0)" ::: "memory");
    __attribute__((address_space(3))) unsigned short* stg = (__attribute__((address_space(3))) unsigned short*)(lds + OST_OFF) + wid * 2048;
    if (MIX != 2) {
#pragma unroll
        for (int r = 0; r < 16; ++r)
#pragma unroll
            for (int d0v = 0; d0v < 2; ++d0v) stg[crow(r, hi) * 64 + d0v * 32 + r32] = (unsigned short)(pg8::cvt_pk_bf16(o[0][d0v][r] * rl[0][r], 0.f) & 0xffffu);
    } else {
        const float g0 = P.subln[r32] * P.omli, g1 = P.subln[32 + r32] * P.omli;
#pragma unroll
        for (int r = 0; r < 16; ++r) {
            const float v0 = o[0][0][r] * rl[0][r] - P.lam * (o[NC - 1][0][r] * rl[NC - 1][r]);
            const float v1 = o[0][1][r] * rl[0][r] - P.lam * (o[NC - 1][1][r] * rl[NC - 1][r]);
            float ss = v0 * v0 + v1 * v1;
            ss += __shfl_xor(ss, 1); ss += __shfl_xor(ss, 2); ss += __shfl_xor(ss, 4); ss += __shfl_xor(ss, 8); ss += __shfl_xor(ss, 16);
            const float rr = rsqrtf(ss * (1.0f / 64.0f) + EPS);
            stg[crow(r, hi) * 64 + r32] = (unsigned short)(pg8::cvt_pk_bf16(v0 * rr * g0, 0.f) & 0xffffu);
            stg[crow(r, hi) * 64 + 32 + r32] = (unsigned short)(pg8::cvt_pk_bf16(v1 * rr * g1, 0.f) & 0xffffu);
        }
    }
    asm volatile("s_waitcnt lgkmcnt(0)" ::: "memory");
    unsigned short* Ow = P.O + (rowb + q0 + wid * 32) * P.op + P.oc + h * P.ohs;
#pragma unroll
    for (int i = 0; i < 4; ++i) { const int row = i * 8 + (lane >> 3), ch = lane & 7;
        const pg8::u32x4 v = *(const __attribute__((address_space(3))) pg8::u32x4*)(stg + row * 64 + ch * 8);
        asm volatile("global_store_dwordx4 %0, %1, off sc1\n\ts_nop 1" :: "v"(Ow + (size_t)row * P.op + ch * 8), "v"(v) : "memory"); }
    asm volatile("s_waitcnt vmcnt(0) lgkmcnt(0)" ::: "memory");
    if (lane == 0) __hip_atomic_fetch_add(P.done + (b * 8 + qb) * 16, 1u, __ATOMIC_RELAXED, __HIP_MEMORY_SCOPE_AGENT);
}
}
#define GAS __attribute__((address_space(1)))
#define LAS __attribute__((address_space(3)))
typedef unsigned short bf16;
typedef unsigned v4u __attribute__((ext_vector_type(4)));
typedef unsigned v2u __attribute__((ext_vector_type(2)));
typedef float f32x4 __attribute__((ext_vector_type(4)));
constexpr int NWAVES = 8;
constexpr int LDS_BYTES = 147456;
constexpr int LDS_MISC = 131072;
#define LDS_WAIT() asm volatile("s_waitcnt lgkmcnt(0)" ::: "memory")
#define VM_WAIT() asm volatile("s_waitcnt vmcnt(0)" ::: "memory")
__device__ __forceinline__ unsigned pk2(float lo, float hi) { return pg8::cvt_pk_bf16(lo, hi); }
__device__ __forceinline__ bf16 f2bf(float v) { return (bf16)(pg8::cvt_pk_bf16(v, 0.f) & 0xffffu); }
__device__ __forceinline__ float bf2f(unsigned short b) { return __uint_as_float((unsigned)b << 16); }
constexpr float LOG2E = 1.4426950408889634f;

struct Args {
    const float* in[23];
    float* out;
    unsigned char* ws;
    int phase, layer, rep, pad1;
};
constexpr size_t MiB = 1u << 20, KiB = 1u << 10;
constexpr size_t WS_CTL = 0;
constexpr size_t CTL_BYTES = 64 * KiB;
constexpr size_t CTL_CNT = 0;
constexpr size_t CTL_ATTQ = 4 * KiB;
constexpr size_t CTL_MOEQ = 8 * KiB;
constexpr size_t CTL_SEAM = 16 * KiB;
constexpr size_t CTL_BAR = 48 * KiB;
constexpr size_t WS_RA = 1 * MiB;
constexpr size_t WS_RF = WS_RA + 64 * KiB;
constexpr size_t WS_KROPE = WS_RF + 64 * KiB;
constexpr size_t WS_CS32 = WS_KROPE + 1 * MiB;
constexpr size_t WS_CS64 = WS_CS32 + 256 * KiB;
constexpr size_t WS_SLOTW = 3 * MiB;
constexpr size_t WS_SSQP = 3 * MiB + 256 * KiB;
constexpr size_t WS_LIST = 5 * MiB;
constexpr int LCAP = 16384;
constexpr size_t WS_WSMALL = 7 * MiB;
constexpr size_t WSM_LAYER = 7 * MiB, WSM_IN = 0, WSM_UQ = 4 * MiB, WSM_UKV = 4 * MiB + 640 * KiB, WSM_OUT = 5 * MiB;
constexpr size_t WS_WGU = 21 * MiB;
constexpr size_t WS_WD = 53 * MiB;
constexpr size_t WS_XB = 69 * MiB;
constexpr size_t WS_XA = 101 * MiB;
constexpr size_t WS_U = 165 * MiB;
constexpr size_t WS_QM = 229 * MiB;
constexpr size_t WS_KVM = 247 * MiB;
constexpr size_t WS_SPLIT = 271 * MiB;
constexpr size_t SPL_LAYER = 512 * KiB, SPL_KR = 0, SPL_RT = 128 * KiB;
constexpr size_t WS_END = 272 * MiB;

__device__ __forceinline__ int lane_id() { int ln; asm volatile("v_mbcnt_lo_u32_b32 %0, -1, 0\n\tv_mbcnt_hi_u32_b32 %0, -1, %0" : "=v"(ln)); return ln; }
typedef const __attribute__((address_space(4))) Args* AP;
__device__ __forceinline__ AP launder(AP p) { asm volatile("" : "+s"(p)); return p; }
struct Frame {
    LAS unsigned char* lds;
    int wave, vcu, G;
    int lane;
    __device__ __forceinline__ int lane_() const { return lane; }
};
__device__ __forceinline__ unsigned* seam_ctr(unsigned char* ws, int l, int seam, int blk) { return (unsigned*)(ws + WS_CTL + CTL_SEAM) + ((size_t)((l * 4 + seam) * 64 + blk)) * 16; }
#define F_LANE (lane_id())
#define F_TID (F.wave * 64 + lane_id())

__device__ __forceinline__ void seam_publish(const Frame& F, unsigned* ctr) {
    asm volatile("s_waitcnt vmcnt(0)" ::: "memory");
    __syncthreads();
    if (F.wave == 0 && F_LANE == 0) {
        __builtin_amdgcn_fence(__ATOMIC_RELEASE, "agent");
        asm volatile("s_waitcnt vmcnt(0)" ::: "memory");
        __hip_atomic_fetch_add(ctr, 1u, __ATOMIC_RELAXED, __HIP_MEMORY_SCOPE_AGENT);
    }
}
__device__ __forceinline__ void seam_wait(const Frame& F, unsigned* ctr, unsigned need) {
    if (F.wave == 0 && F_LANE == 0) {
        unsigned sp = 0;
        while (__hip_atomic_load(ctr, __ATOMIC_RELAXED, __HIP_MEMORY_SCOPE_AGENT) < need) { __builtin_amdgcn_s_sleep(1); if (++sp > (1u << 24)) break; }
        __builtin_amdgcn_fence(__ATOMIC_ACQUIRE, "agent");
        asm volatile("s_waitcnt vmcnt(0)" ::: "memory");
    }
    __syncthreads();
}
__device__ __forceinline__ float2 cossin_f(float ang) {
    const double x = (double)ang;
    const double k = rint(x * 0.15915494309189535);
    double r = fma(-k, 6.283185307179586, x);
    float sg = 1.f;
    if (r > 1.5707963267948966) { r = 3.141592653589793 - r; sg = -1.f; } else if (r < -1.5707963267948966) { r = -3.141592653589793 - r; sg = -1.f; }
    const float t = (float)r, t2 = t * t;
    float sp = 1.0f / 6227020800.0f;
    sp = fmaf(sp, t2, -1.0f / 39916800.0f); sp = fmaf(sp, t2, 1.0f / 362880.0f); sp = fmaf(sp, t2, -1.0f / 5040.0f); sp = fmaf(sp, t2, 1.0f / 120.0f); sp = fmaf(sp, t2, -1.0f / 6.0f);
    const float sn = fmaf(sp * t2, t, t);
    float cp = 1.0f / 479001600.0f;
    cp = fmaf(cp, t2, -1.0f / 3628800.0f); cp = fmaf(cp, t2, 1.0f / 40320.0f); cp = fmaf(cp, t2, -1.0f / 720.0f); cp = fmaf(cp, t2, 1.0f / 24.0f); cp = fmaf(cp, t2, -0.5f);
    const float cn = fmaf(cp, t2, 1.0f);
    return make_float2(sg * cn, sn);
}
__device__ __forceinline__ void transpose_item2(const float* srcA, int cA, const float* srcB, int cB, int ldw, const float* gain, bf16* WT, int ldt, int k0, int n0d, LAS float* scr, int lane) {
    (void)scr;
    const int n4 = lane & 7, kg = lane >> 3;
    const float* sp = ((n4 < 4) ? srcA + cA + 4 * n4 : srcB + cB + 4 * (n4 - 4)) + (size_t)(k0 + kg * 8) * ldw;
    f32x4 v[8];
#pragma unroll
    for (int r = 0; r < 8; ++r) v[r] = *(const f32x4*)(sp + (size_t)r * ldw);
    if (gain) {
        const f32x4 g0 = *(const f32x4*)(gain + k0 + kg * 8), g1 = *(const f32x4*)(gain + k0 + kg * 8 + 4);
#pragma unroll
        for (int r = 0; r < 4; ++r) { v[r] = v[r] * g0[r]; v[4 + r] = v[4 + r] * g1[r]; }
    }
#pragma unroll
    for (int c = 0; c < 4; ++c) {
        v4u o; o.x = pk2(v[0][c], v[1][c]); o.y = pk2(v[2][c], v[3][c]); o.z = pk2(v[4][c], v[5][c]); o.w = pk2(v[6][c], v[7][c]);
        *(GAS v4u*)(WT + (size_t)(n0d + 4 * n4 + c) * ldt + k0 + kg * 8) = o;
    }
}
__device__ __forceinline__ void ucol_src(int G32, int& cA, int& cB) {
    const int c = G32 * 32;
    if (c < 640) { cA = c; cB = c + 16; }
    else if (c < 1152) {
        const int rel = c - 640, hh = rel / 64, gi = (rel % 64) / 32; const int base = 672 + hh * 64;
        cA = base + 16 * gi; cB = base + 32 + 16 * gi; }
    else { cA = c + 32; cB = c + 48; }
}
constexpr int P0_I_IN = 16 * 64, P0_I_UQ = 6 * 24, P0_I_UKV = 4 * 24, P0_I_OUT = 16 * 32, P0_I_L = P0_I_IN + P0_I_UQ + P0_I_UKV + P0_I_OUT;
__device__ __forceinline__ void p0_item(const Frame& F, AP a, int l, int r, int lane_) {
    LAS float* scr = nullptr;
    unsigned char* wl = a->ws + WS_WSMALL + (size_t)l * WSM_LAYER;
    if (r < P0_I_IN) { const int kb = r / 64, nb = r % 64; int cA, cB; ucol_src(nb, cA, cB); const float* W = a->in[2] + (size_t)l * D * INW;
        transpose_item2(W, cA, W, cB, INW, a->in[1] + l * D, (bf16*)(wl + WSM_IN), 1024, kb * 64, nb * 32, scr, lane_); return; }
    r -= P0_I_IN;
    if (r < P0_I_UQ) { const int kb = r / 24, nb = r % 24; bf16* WT = (bf16*)(wl + WSM_UQ);
        if (nb < 18) { const float* W = a->in[5] + (size_t)l * 384 * 576; transpose_item2(W, nb * 32, W, nb * 32 + 16, 576, a->in[3] + l * 384, WT, 384, kb * 64, nb * 32, scr, lane_); }
        else { for (int n = 0; n < 32; ++n) WT[(size_t)(nb * 32 + n) * 384 + kb * 64 + lane_] = 0; }
        return; }
    r -= P0_I_UQ;
    if (r < P0_I_UKV) { const int kb = r / 24, nb = r % 24; const float* W = a->in[6] + (size_t)l * 256 * 768;
        transpose_item2(W, nb * 32, W, nb * 32 + 16, 768, a->in[4] + l * 256, (bf16*)(wl + WSM_UKV), 256, kb * 64, nb * 32, scr, lane_); return; }
    r -= P0_I_UKV;
    { const int kb = r / 32, nb = r % 32; const float* W = a->in[13] + (size_t)l * D * D;
        transpose_item2(W, nb * 32, W, nb * 32 + 16, D, nullptr, (bf16*)(wl + WSM_OUT), 1024, kb * 64, nb * 32, scr, lane_); }
}
constexpr int P0_FIRST = P0_I_L, P0_REST = P0_I_L, P0_REST_CHUNKS = (P0_REST + 63) / 64;
__device__ __forceinline__ void p0_rest_chunk(const Frame& F, AP a, int u) {
#pragma unroll 1
    for (int k = 0; k < 8; ++k) {
        const int j = u * 64 + k * 8 + F.wave;
        int ln = lane_id(); asm volatile("" : "+v"(ln));
        if (j < P0_REST) p0_item(F, a, 1, j, ln);
    }
}
__device__ __forceinline__ void p0_small(const Frame& F, AP a) {
    const int gw = F.vcu * NWAVES + F.wave, NGW = F.G * NWAVES;
#pragma unroll 1
    for (int it = gw; it < P0_FIRST; it += NGW) p0_item(F, a, 0, it, F_LANE);
    float2* cs32 = (float2*)(a->ws + WS_CS32); float2* cs64 = (float2*)(a->ws + WS_CS64);
#pragma unroll 1
    for (int i = F.vcu * 512 + F_TID; i < S * 32; i += F.G * 512) {
        { const int s = i / 32, f = i % 32; const float inv = 1.0f / powf(10000.0f, (float)(2 * f) / 64.0f); const float ang = (float)s * inv;
          cs64[i] = cossin_f(ang); }
        if (i < S * 16) { const int s = i / 16, f = i % 16; const float inv = 1.0f / powf(10000.0f, (float)(2 * f) / 32.0f); const float ang = (float)s * inv;
          cs32[i] = cossin_f(ang); }
    }
#pragma unroll 1
    for (int i = F.vcu * 512 + F_TID; i < 2 * 80 * 128; i += F.G * 512) {
        const int l = i / (80 * 128), rem = i % (80 * 128), k8 = rem / 80, n = rem % 80;
        const bool kr = n < 32; const int nn = kr ? n : n - 32;
        const float* gain = (kr ? a->in[1] : a->in[14]) + l * D;
        float v[8];
#pragma unroll
        for (int r = 0; r < 8; ++r) {
            const int k = k8 * 8 + r; float wv = 0.f;
            if (kr) wv = a->in[2][(size_t)l * D * INW + (size_t)k * INW + 640 + nn];
            else if (nn < 32) wv = a->in[17][(size_t)l * D * 32 + k * 32 + nn];
            else if (nn < 36) wv = a->in[15][(size_t)l * D * 4 + k * 4 + (nn - 32)];
            v[r] = wv * gain[k];
        }
        v4u hi, lo;
        hi.x = pk2(v[0], v[1]); hi.y = pk2(v[2], v[3]); hi.z = pk2(v[4], v[5]); hi.w = pk2(v[6], v[7]);
        lo.x = pk2(v[0] - __uint_as_float(hi.x << 16), v[1] - __uint_as_float(hi.x & 0xffff0000u)); lo.y = pk2(v[2] - __uint_as_float(hi.y << 16), v[3] - __uint_as_float(hi.y & 0xffff0000u));
        lo.z = pk2(v[4] - __uint_as_float(hi.z << 16), v[5] - __uint_as_float(hi.z & 0xffff0000u)); lo.w = pk2(v[6] - __uint_as_float(hi.w << 16), v[7] - __uint_as_float(hi.w & 0xffff0000u));
        bf16* dst = (bf16*)(a->ws + WS_SPLIT + (size_t)l * SPL_LAYER + (kr ? SPL_KR : SPL_RT)) + (size_t)nn * 1024 + k8 * 8;
        *(v4u*)dst = hi; *(v4u*)(dst + (kr ? 32 : 48) * 1024) = lo;
    }
}
__device__ __forceinline__ void p0_experts(const Frame& F, AP a, int l) {
    LAS float* scr = (LAS float*)(F.lds + F.wave * 16384);
    const int gw = F.vcu * NWAVES + F.wave, NGW = F.G * NWAVES;
    constexpr int I_GU = 16 * 16, I_D = 4 * 32, I_E = I_GU + I_D;
    const float* Wg = a->in[19] + (size_t)l * NE * D * FF; const float* Wu = a->in[20] + (size_t)l * NE * D * FF; const float* Wdn = a->in[21] + (size_t)l * NE * FF * D;
#pragma unroll 1
    for (int it = gw; it < NE * I_E; it += NGW) {
        const int e = it / I_E; int r = it % I_E;
        if (r < I_GU) { const int kb = r / 16, nb = r % 16;
            transpose_item2(Wg + (size_t)e * D * FF, nb * 16, Wu + (size_t)e * D * FF, nb * 16, FF, a->in[14] + l * D, (bf16*)(a->ws + WS_WGU) + (size_t)e * 512 * 1024, 1024, kb * 64, nb * 32, scr, F_LANE); }
        else { r -= I_GU; const int kb = r / 32, nb = r % 32; const float* W = Wdn + (size_t)e * FF * D;
            transpose_item2(W, nb * 32, W, nb * 32 + 16, D, nullptr, (bf16*)(a->ws + WS_WD) + (size_t)e * 1024 * 256, 256, kb * 64, nb * 32, scr, F_LANE); }
    }
}

constexpr int CONV_CHUNKS = NE * 384 / 64;
#ifndef CONV_MOD
#define CONV_MOD 6
#endif
struct TItem { f32x4 v[8]; f32x4 g0, g1; };
__device__ __forceinline__ void ti_load(TItem& t, const float* srcA, int cA, const float* srcB, int cB, int ldw, const float* gain, int k0, int lane) {
    const int n4 = lane & 7, kg = lane >> 3;
    const float* sp = ((n4 < 4) ? srcA + cA + 4 * n4 : srcB + cB + 4 * (n4 - 4)) + (size_t)(k0 + kg * 8) * ldw;
#pragma unroll
    for (int r = 0; r < 8; ++r) t.v[r] = __builtin_nontemporal_load((const f32x4*)(sp + (size_t)r * ldw));
    if (gain) { t.g0 = *(const f32x4*)(gain + k0 + kg * 8); t.g1 = *(const f32x4*)(gain + k0 + kg * 8 + 4); }
}
__device__ __forceinline__ void ti_store(TItem& t, bool gain, bf16* WT, int ldt, int k0, int n0d, int lane) {
    const int n4 = lane & 7, kg = lane >> 3;
    if (gain) {
#pragma unroll
        for (int r = 0; r < 4; ++r) { t.v[r] = t.v[r] * t.g0[r]; t.v[4 + r] = t.v[4 + r] * t.g1[r]; }
    }
#pragma unroll
    for (int c = 0; c < 4; ++c) {
        v4u o; o.x = pk2(t.v[0][c], t.v[1][c]); o.y = pk2(t.v[2][c], t.v[3][c]); o.z = pk2(t.v[4][c], t.v[5][c]); o.w = pk2(t.v[6][c], t.v[7][c]);
        *(GAS v4u*)(WT + (size_t)(n0d + 4 * n4 + c) * ldt + k0 + kg * 8) = o;
    }
}
__device__ __forceinline__ void conv_chunk(const Frame& F, AP a, int l, int u) {
    const int e = u / 6, c6 = u % 6, lane = F_LANE;
    const bool gu = c6 < 4;
    const float* sA; const float* sB; int ldw, ldt; const float* gain; bf16* WT;
    if (gu) { sA = a->in[19] + ((size_t)l * NE + e) * D * FF; sB = a->in[20] + ((size_t)l * NE + e) * D * FF; ldw = FF; ldt = 1024; gain = a->in[14] + l * D; WT = (bf16*)(a->ws + WS_WGU) + (size_t)e * 512 * 1024; }
    else { sA = sB = a->in[21] + ((size_t)l * NE + e) * FF * D; ldw = D; ldt = 256; gain = nullptr; WT = (bf16*)(a->ws + WS_WD) + (size_t)e * 1024 * 256; }
    const int rbase = (gu ? c6 * 64 : (c6 - 4) * 64) + F.wave;
#define CV_LOAD(T, k) do { const int r = rbase + 8 * (k); const int kb = gu ? r / 16 : r / 32, nb = gu ? r % 16 : r % 32; \
        ti_load(T, sA, gu ? nb * 16 : nb * 32, sB, gu ? nb * 16 : nb * 32 + 16, ldw, gain, kb * 64, lane); } while (0)
#define CV_STORE(T, k) do { const int r = rbase + 8 * (k); const int kb = gu ? r / 16 : r / 32, nb = gu ? r % 16 : r % 32; \
        ti_store(T, gu, WT, ldt, kb * 64, nb * 32, lane); } while (0)
    TItem t0, t1;
    CV_LOAD(t0, 0); CV_LOAD(t1, 1);
    __builtin_amdgcn_sched_barrier(0);
#pragma unroll 1
    for (int k = 0; k < 6; k += 2) {
        CV_STORE(t0, k); __builtin_amdgcn_sched_barrier(0); CV_LOAD(t0, k + 2); __builtin_amdgcn_sched_barrier(0);
        CV_STORE(t1, k + 1); __builtin_amdgcn_sched_barrier(0); CV_LOAD(t1, k + 3); __builtin_amdgcn_sched_barrier(0);
    }
    CV_STORE(t0, 6); CV_STORE(t1, 7);
#undef CV_LOAD
#undef CV_STORE
}

__device__ __forceinline__ float reduce32(const float (&a)[32], int lane) {
    float b16[16], b8[8], b4[4], b2[2];
#pragma unroll
    for (int o = 0; o < 16; ++o) { const float send = (lane & 32) ? a[o] : a[o + 16], keep = (lane & 32) ? a[o + 16] : a[o]; b16[o] = keep + __shfl_xor(send, 32); }
#pragma unroll
    for (int o = 0; o < 8; ++o) { const float send = (lane & 16) ? b16[o] : b16[o + 8], keep = (lane & 16) ? b16[o + 8] : b16[o]; b8[o] = keep + __shfl_xor(send, 16); }
#pragma unroll
    for (int o = 0; o < 4; ++o) { const float send = (lane & 8) ? b8[o] : b8[o + 4], keep = (lane & 8) ? b8[o + 4] : b8[o]; b4[o] = keep + __shfl_xor(send, 8); }
#pragma unroll
    for (int o = 0; o < 2; ++o) { const float send = (lane & 4) ? b4[o] : b4[o + 2], keep = (lane & 4) ? b4[o + 2] : b4[o]; b2[o] = keep + __shfl_xor(send, 4); }
    const float send = (lane & 2) ? b2[0] : b2[1], keep = (lane & 2) ? b2[1] : b2[0];
    float v = keep + __shfl_xor(send, 2);
    v += __shfl_xor(v, 1);
    return v;
}

template <int MODE>
__device__ __forceinline__ void norm_pass(const Frame& F, AP a, int l) {
    const int gw = F.vcu * NWAVES + F.wave, NGW = F.G * NWAVES, lane = F_LANE;
    const float* g = a->in[22];
    const float* XA = (const float*)(a->ws + WS_XA);
    const bf16* ys = (const bf16*)(a->ws + WS_U);
#pragma unroll 1
    for (int t0 = gw * 4; t0 < T; t0 += NGW * 4) {
        float xv[4][16]; v2u yy[4][8];
#pragma unroll
        for (int tk = 0; tk < 4; ++tk) {
            const int t = t0 + tk;
#pragma unroll
            for (int j = 0; j < 4; ++j) {
                const float4 v = *(const float4*)(XA + (size_t)t * D + j * 256 + lane * 4);
                xv[tk][j * 4 + 0] = v.x; xv[tk][j * 4 + 1] = v.y; xv[tk][j * 4 + 2] = v.z; xv[tk][j * 4 + 3] = v.w;
                yy[tk][j] = *(const v2u*)(ys + (size_t)(2 * t) * D + j * 256 + lane * 4); yy[tk][4 + j] = *(const v2u*)(ys + (size_t)(2 * t + 1) * D + j * 256 + lane * 4);
            }
        }
#pragma unroll
        for (int tk = 0; tk < 4; ++tk) {
            const int t = t0 + tk;
            float ss = 0.f;
#pragma unroll
            for (int j = 0; j < 4; ++j) {
                const v2u y0 = yy[tk][j], y1 = yy[tk][4 + j];
                xv[tk][j * 4 + 0] += __uint_as_float(y0.x << 16) + __uint_as_float(y1.x << 16); xv[tk][j * 4 + 1] += __uint_as_float(y0.x & 0xffff0000u) + __uint_as_float(y1.x & 0xffff0000u);
                xv[tk][j * 4 + 2] += __uint_as_float(y0.y << 16) + __uint_as_float(y1.y << 16); xv[tk][j * 4 + 3] += __uint_as_float(y0.y & 0xffff0000u) + __uint_as_float(y1.y & 0xffff0000u);
#pragma unroll
                for (int q = 0; q < 4; ++q) ss += xv[tk][j * 4 + q] * xv[tk][j * 4 + q];
            }
            ss = wave_sum(ss);
            const float r = rsqrtf(ss / (float)D + EPS);
#pragma unroll
            for (int j = 0; j < 4; ++j) { const float4 gg = *(const float4*)(g + j * 256 + lane * 4);
                *(float4*)(a->out + (size_t)t * D + j * 256 + lane * 4) = make_float4(xv[tk][j * 4 + 0] * r * gg.x, xv[tk][j * 4 + 1] * r * gg.y, xv[tk][j * 4 + 2] * r * gg.z, xv[tk][j * 4 + 3] * r * gg.w); }
        }
    }
}

constexpr int LP_RS = 2064;
constexpr int LP_LO = 32 * LP_RS;
constexpr int LDS_MISC2 = 135168;
#ifndef LP_PREF
#define LP_PREF(K) ((K) != 1)
#endif
#define LP_BAR() asm volatile("s_waitcnt lgkmcnt(0)\n\ts_barrier" ::: "memory")
template <int KIND>
__device__ __forceinline__ void light_pass(const Frame& F, AP a, int l, int rrp = 0) {
    constexpr int NT = (KIND == 3) ? 3 : 2;
    const int lane = F_LANE, w = F.wave, tid = F_TID;
    LAS float* part = (LAS float*)F.lds;
    LAS int* hist = (LAS int*)(F.lds + LDS_MISC2);
    LAS int* tokinfo = hist + 64;
    LAS float* rls = (LAS float*)(F.lds + LDS_MISC2 + 2048);
    const pg8::bf16_t* wsp = (const pg8::bf16_t*)(a->ws + WS_SPLIT + (size_t)l * SPL_LAYER + (KIND == 3 ? SPL_RT : SPL_KR));
    const float* brg = a->in[16] + l * 4; const float* bre = a->in[18] + l * 32;
    float* XA = (float*)(a->ws + WS_XA);
    float* rout = (float*)(a->ws + (KIND == 3 ? WS_RF : WS_RA));
    bf16* xb = (bf16*)(a->ws + WS_XB); bf16* krope = (bf16*)(a->ws + WS_KROPE);
    const bf16* ys = (const bf16*)(a->ws + WS_U);
    const float2* cs32 = (const float2*)(a->ws + WS_CS32);
    float* slot_w = (float*)(a->ws + WS_SLOTW); int* list = (int*)(a->ws + WS_LIST);
    int* cnt = (int*)(a->ws + WS_CTL + CTL_CNT) + (l + 2 * rrp) * 32;
    const int tbase = F.vcu * 64;
    if (KIND == 3) seam_wait(F, seam_ctr(a->ws, l, 0, F.vcu / 4), 4u);
    if (KIND == 3) { if (tid < 64) hist[tid] = 0; }
    const int fr = lane & 15, fk = lane >> 4;
    f32x4 xq[4][4]; v2u yq[KIND == 1 ? 4 : 1][4][2];
    auto loadx = [&](int half) {
#pragma unroll
        for (int tk = 0; tk < 4; ++tk) {
            const int t = tbase + half * 32 + 4 * w + tk;
            const float* xr = (KIND == 0 ? a->in[0] : XA) + (size_t)t * D;
#pragma unroll
            for (int j = 0; j < 4; ++j) {
                xq[tk][j] = *(const f32x4*)(xr + j * 256 + lane * 4);
                if (KIND == 1) { yq[KIND == 1 ? tk : 0][j][0] = *(const v2u*)(ys + (size_t)(2 * t) * D + j * 256 + lane * 4); yq[KIND == 1 ? tk : 0][j][1] = *(const v2u*)(ys + (size_t)(2 * t + 1) * D + j * 256 + lane * 4); }
            }
        }
    };
    float brgv[4] = {0.f, 0.f, 0.f, 0.f}, brev = 0.f; float2 csq[2][4];
    if (KIND == 3) {
#pragma unroll
        for (int o = 0; o < 4; ++o) brgv[o] = brg[o];
        brev = bre[lane & 31];
    } else if (LP_PREF(KIND)) {
#pragma unroll
        for (int hh = 0; hh < 2; ++hh)
#pragma unroll
            for (int tk = 0; tk < 4; ++tk) {
                if (KIND == 0) { const float inv = 1.0f / powf(10000.0f, (float)(2 * (lane & 15)) / 32.0f); csq[hh][tk] = cossin_f((float)((tbase + hh * 32 + 4 * w + tk) % S) * inv); }
                else csq[hh][tk] = cs32[((tbase + hh * 32 + 4 * w + tk) % S) * 16 + (lane & 15)];
            }
    }
    constexpr bool PREF = LP_PREF(KIND);
    if (PREF) loadx(0);
    pg8::bf16x8 bH[4][NT], bL[4][NT];
    if (KIND == 0) {
        const float* W = a->in[2] + (size_t)l * D * INW + 640; const float* gn = a->in[1] + l * D;
#pragma unroll
        for (int u = 0; u < 4; ++u) {
            const int k0 = w * 128 + u * 32 + fk * 8;
            const f32x4 g0 = *(const f32x4*)(gn + k0), g1 = *(const f32x4*)(gn + k0 + 4);
#pragma unroll
            for (int nt = 0; nt < NT; ++nt) {
                float v[8];
#pragma unroll
                for (int r = 0; r < 8; ++r) v[r] = W[(size_t)(k0 + r) * INW + nt * 16 + fr] * (r < 4 ? g0[r & 3] : g1[r & 3]);
                v4u hi, lo;
                hi.x = pk2(v[0], v[1]); hi.y = pk2(v[2], v[3]); hi.z = pk2(v[4], v[5]); hi.w = pk2(v[6], v[7]);
                lo.x = pk2(v[0] - __uint_as_float(hi.x << 16), v[1] - __uint_as_float(hi.x & 0xffff0000u)); lo.y = pk2(v[2] - __uint_as_float(hi.y << 16), v[3] - __uint_as_float(hi.y & 0xffff0000u));
                lo.z = pk2(v[4] - __uint_as_float(hi.z << 16), v[5] - __uint_as_float(hi.z & 0xffff0000u)); lo.w = pk2(v[6] - __uint_as_float(hi.w << 16), v[7] - __uint_as_float(hi.w & 0xffff0000u));
                bH[u][nt < NT ? nt : 0] = __builtin_bit_cast(pg8::bf16x8, hi); bL[u][nt < NT ? nt : 0] = __builtin_bit_cast(pg8::bf16x8, lo);
            }
        }
    } else {
        const pg8::bf16_t* bh = wsp + (size_t)fr * 1024 + w * 128 + fk * 8;
#pragma unroll
        for (int u = 0; u < 4; ++u)
#pragma unroll
            for (int nt = 0; nt < NT; ++nt) { bH[u][nt] = *(const pg8::bf16x8*)(bh + (size_t)nt * 16 * 1024 + u * 32); bL[u][nt] = *(const pg8::bf16x8*)(bh + (size_t)(NT * 16 + nt * 16) * 1024 + u * 32); }
    }
    LP_BAR();
#pragma unroll
    for (int half = 0; half < 2; ++half) {
        {
            if (!PREF) loadx(half);
#pragma unroll
            for (int tk = 0; tk < 4; ++tk) {
                const int ti = 4 * w + tk, t = tbase + half * 32 + ti;
                float ss = 0.f;
#pragma unroll
                for (int j = 0; j < 4; ++j) {
                    f32x4 v = xq[tk][j];
                    if (KIND == 1) {
                        const v2u y0 = yq[KIND == 1 ? tk : 0][j][0], y1 = yq[KIND == 1 ? tk : 0][j][1];
                        v[0] += __uint_as_float(y0.x << 16) + __uint_as_float(y1.x << 16); v[1] += __uint_as_float(y0.x & 0xffff0000u) + __uint_as_float(y1.x & 0xffff0000u);
                        v[2] += __uint_as_float(y0.y << 16) + __uint_as_float(y1.y << 16); v[3] += __uint_as_float(y0.y & 0xffff0000u) + __uint_as_float(y1.y & 0xffff0000u);
                        *(f32x4*)(XA + (size_t)t * D + j * 256 + lane * 4) = v;
                    }
                    ss += (v[0] * v[0] + v[1] * v[1]) + (v[2] * v[2] + v[3] * v[3]);
                    v2u o; o.x = pk2(v[0], v[1]); o.y = pk2(v[2], v[3]); *(v2u*)(xb + (size_t)t * D + j * 256 + lane * 4) = o;
                    v2u q; q.x = pk2(v[0] - __uint_as_float(o.x << 16), v[1] - __uint_as_float(o.x & 0xffff0000u));
                    q.y = pk2(v[2] - __uint_as_float(o.y << 16), v[3] - __uint_as_float(o.y & 0xffff0000u));
                    *(LAS v2u*)(F.lds + ti * LP_RS + (j * 256 + lane * 4) * 2) = o;
                    *(LAS v2u*)(F.lds + LP_LO + ti * LP_RS + (j * 256 + lane * 4) * 2) = q;
                }
                ss = wave_sum(ss);
                const float r = rsqrtf(ss / (float)D + EPS);
                if (lane == 0) { rout[t] = r; rls[ti] = r; }
            }
            if (PREF && half == 0) { __builtin_amdgcn_sched_barrier(0); loadx(1); __builtin_amdgcn_sched_barrier(0); }
        }
        LP_BAR();
        f32x4 acc[2][NT];
#pragma unroll
        for (int mt = 0; mt < 2; ++mt)
#pragma unroll
            for (int nt = 0; nt < NT; ++nt) acc[mt][nt] = (f32x4){0.f, 0.f, 0.f, 0.f};
        {
            const LAS unsigned char* ah = F.lds + fr * LP_RS + (w * 128 + fk * 8) * 2;
#pragma unroll
            for (int u = 0; u < 4; ++u)
#pragma unroll
                for (int mt = 0; mt < 2; ++mt) {
                    const pg8::bf16x8 aH = *(const LAS pg8::bf16x8*)(ah + mt * 16 * LP_RS + u * 64), aL = *(const LAS pg8::bf16x8*)(ah + LP_LO + mt * 16 * LP_RS + u * 64);
#pragma unroll
                    for (int nt = 0; nt < NT; ++nt) {
                        acc[mt][nt] = __builtin_amdgcn_mfma_f32_16x16x32_bf16(aH, bH[u][nt], acc[mt][nt], 0, 0, 0);
                        acc[mt][nt] = __builtin_amdgcn_mfma_f32_16x16x32_bf16(aL, bH[u][nt], acc[mt][nt], 0, 0, 0);
                        acc[mt][nt] = __builtin_amdgcn_mfma_f32_16x16x32_bf16(aH, bL[u][nt], acc[mt][nt], 0, 0, 0);
                    }
                }
        }
        LP_BAR();
#pragma unroll
        for (int mt = 0; mt < 2; ++mt)
#pragma unroll
            for (int nt = 0; nt < NT; ++nt)
#pragma unroll
                for (int rg = 0; rg < 4; ++rg) part[(w * 32 + mt * 16 + 4 * fk + rg) * 48 + nt * 16 + fr] = acc[mt][nt][rg];
        LP_BAR();
        float2 cq0 = make_float2(0.f, 0.f), cq1 = cq0, cq2 = cq0, cq3 = cq0;
        if (PREF && KIND != 3) { cq0 = csq[half][0]; cq1 = csq[half][1]; cq2 = csq[half][2]; cq3 = csq[half][3]; }
#pragma unroll 1
        for (int tk = 0; tk < 4; ++tk) {
            const int ti = 4 * w + tk, i = half * 32 + ti, t = tbase + i;
            float v = 0.f;
            if (lane < NT * 16) v = ((((part[(0 * 32 + ti) * 48 + lane] + part[(1 * 32 + ti) * 48 + lane]) + (part[(2 * 32 + ti) * 48 + lane] + part[(3 * 32 + ti) * 48 + lane]))
                                    + ((part[(4 * 32 + ti) * 48 + lane] + part[(5 * 32 + ti) * 48 + lane]) + (part[(6 * 32 + ti) * 48 + lane] + part[(7 * 32 + ti) * 48 + lane])))) * rls[ti];
            if (KIND != 3) {
                const float partner = __shfl_xor(v, 16);
                const int oo = lane & 31;
                float2 c = cq0; cq0 = cq1; cq1 = cq2; cq2 = cq3;
                if (!PREF) c = cs32[(t % S) * 16 + (oo & 15)];
                const float ro = (oo < 16) ? (v * c.x - partner * c.y) : (v * c.x + partner * c.y);
                if (lane < 32) krope[(size_t)t * 32 + oo] = f2bf(ro);
            } else {
                float gl[4];
#pragma unroll
                for (int o = 0; o < 4; ++o) gl[o] = __shfl(v, 32 + o) + brgv[o];
                int gi = 0; float gm = gl[0];
#pragma unroll
                for (int o = 1; o < 4; ++o) if (gl[o] > gm) { gm = gl[o]; gi = o; }
                float gs = 0.f;
#pragma unroll
                for (int o = 0; o < 4; ++o) gs += expf(gl[o] - gm);
                const float ggate = 1.0f / gs;
                const float evb = v + brev;
                float ein[8];
#pragma unroll
                for (int k = 0; k < 8; ++k) ein[k] = __shfl(evb, 8 * gi + k);
                int i1 = 0; float v1 = ein[0];
#pragma unroll
                for (int k = 1; k < 8; ++k) if (ein[k] > v1) { v1 = ein[k]; i1 = k; }
                int i2 = -1; float v2 = -INFINITY;
#pragma unroll
                for (int k = 0; k < 8; ++k) if (k != i1 && ein[k] > v2) { v2 = ein[k]; i2 = k; }
                if (i2 < 0) i2 = (i1 + 1) & 7;
                const float e2 = expf(v2 - v1);
                if (lane == 0) {
                    slot_w[t * 2 + 0] = ggate / (1.0f + e2); slot_w[t * 2 + 1] = ggate * e2 / (1.0f + e2);
                    const int ea = gi * 8 + i1, eb = gi * 8 + i2;
                    tokinfo[i * 4 + 0] = ea; tokinfo[i * 4 + 1] = eb;
                    tokinfo[i * 4 + 2] = __hip_atomic_fetch_add(hist + ea, 1, __ATOMIC_RELAXED, __HIP_MEMORY_SCOPE_WORKGROUP); tokinfo[i * 4 + 3] = __hip_atomic_fetch_add(hist + eb, 1, __ATOMIC_RELAXED, __HIP_MEMORY_SCOPE_WORKGROUP);
                }
            }
        }
        LP_BAR();
    }
    if (KIND == 3) {
        if (tid < 32) { const int c = hist[tid]; hist[32 + tid] = c ? atomicAdd(cnt + tid, c) : 0; }
        __syncthreads();
        if (tid < 128) {
            const int i = tid >> 1, k = tid & 1, e = tokinfo[i * 4 + k], rank = tokinfo[i * 4 + 2 + k];
            list[(size_t)e * LCAP + hist[32 + e] + rank] = (tbase + i) * 2 + k;
        }
        __syncthreads();
    }
}

struct DenseOrder {
    int nM, nN, G, c; const pg8::bf16_t* Bt; int ldb;
    __device__ __forceinline__ bool next(int i, pg8::Unit& u) const {
        const int L = i * G + c; if (L >= nM * nN) return false;
        u.pm = L / nN; u.pn = L % nN; u.e = 0; u.cnt = 256; u.tau = 0; return true;
    }
    __device__ __forceinline__ unsigned arow(const pg8::Unit& u, int r) const { return (unsigned)(u.pm * 256 + r); }
    __device__ __forceinline__ const pg8::bf16_t* bbase(const pg8::Unit& u) const { return Bt + (size_t)u.pn * 256 * ldb; }
};

struct EpiU {
    static constexpr bool PERM = false;
    bf16* O; const float* rs; float* ssq; const float2* cs32; const float2* cs64;
    __device__ __forceinline__ void operator()(const pg8::f32x4 (&acc)[2][2][4][2], const pg8::Unit& u, int wr, int wc, int fr, int fq) const {
        const int row0 = u.pm * 256 + wr * 64 + fr;
        float scv[2][4];
#pragma unroll
        for (int ai = 0; ai < 2; ++ai)
#pragma unroll
            for (int m = 0; m < 4; ++m) scv[ai][m] = rs[row0 + ai * 128 + m * 16];
#pragma unroll
        for (int bj = 0; bj < 2; ++bj) {
            const int G32 = u.pn * 8 + bj * 4 + wc, col0 = G32 * 32 + 4 * fq;
            int kind; float qs = 1.f;
            if (G32 < 12) kind = 0; else if (G32 < 20) kind = 1; else if (G32 < 32) { kind = 2; qs = 0.125f * LOG2E; } else if (G32 < 36) kind = 3;
            else if (G32 < 40) kind = 4; else if (G32 < 48) { kind = 5; qs = 0.17677669529663687f * LOG2E; } else if (G32 < 56) kind = 6; else kind = 4;
            const bool rope = (kind > 1) && (kind != 4);
#pragma unroll
            for (int ai = 0; ai < 2; ++ai) {
                pg8::f32x4 ca[4][2];
                if (rope) {
#pragma unroll
                    for (int m = 0; m < 4; ++m) {
                        const int spos = (row0 + ai * 128 + m * 16) % S;
                        const float2* cs = (kind == 2 || kind == 3) ? cs64 + spos * 32 + 16 * (G32 & 1) + 4 * fq : cs32 + spos * 16 + 4 * fq;
                        ca[m][0] = *(const pg8::f32x4*)cs; ca[m][1] = *(const pg8::f32x4*)(cs + 2);
                    }
                    __builtin_amdgcn_sched_barrier(0);
                }
#pragma unroll
                for (int m = 0; m < 4; ++m) {
                    const int row = row0 + ai * 128 + m * 16; const float sc = scv[ai][m];
                    pg8::f32x4 v0 = acc[ai][bj][m][0] * sc, v1 = acc[ai][bj][m][1] * sc;
                    if (kind <= 1) {
                        float s = v0[0] * v0[0] + v0[1] * v0[1] + v0[2] * v0[2] + v0[3] * v0[3] + v1[0] * v1[0] + v1[1] * v1[1] + v1[2] * v1[2] + v1[3] * v1[3];
                        s += __shfl_xor(s, 16); s += __shfl_xor(s, 32);
                        if (fq == 0) ssq[(size_t)row * 20 + G32] = s;
                    } else if (rope) {
#pragma unroll
                        for (int j = 0; j < 4; ++j) { const float cx = ca[m][j >> 1][2 * (j & 1)], cy = ca[m][j >> 1][2 * (j & 1) + 1]; const float x1 = v0[j], x2 = v1[j]; v0[j] = (x1 * cx - x2 * cy) * qs; v1[j] = (x2 * cx + x1 * cy) * qs; }
                    }
                    bf16* rowp = O + (size_t)row * 2048 + col0;
                    v2u w0, w1; w0.x = pk2(v0[0], v0[1]); w0.y = pk2(v0[2], v0[3]); w1.x = pk2(v1[0], v1[1]); w1.y = pk2(v1[2], v1[3]);
                    *(v2u*)rowp = w0; *(v2u*)(rowp + 16) = w1;
                }
                asm volatile("" ::: "memory");
            }
        }
    }
};
__device__ __forceinline__ void p1_gemm(const Frame& F, AP a, int l) {
    pg8::Gemm g{(const pg8::bf16_t*)(a->ws + WS_XB), (const pg8::bf16_t*)(a->ws + WS_WSMALL + (size_t)l * WSM_LAYER + WSM_IN), 1024, 1024, 1024};
    DenseOrder S_{T / 256, 2048 / 256, F.G, F.vcu, g.Bt, 1024};
    EpiU E{(bf16*)(a->ws + WS_U), (const float*)(a->ws + WS_RA), (float*)(a->ws + WS_SSQP), (const float2*)(a->ws + WS_CS32), (const float2*)(a->ws + WS_CS64)};
    pg8::gemm_phase<EpiU, DenseOrder, true>(F.lds, g, S_, E, F.wave, F_LANE);
}

struct EpiQ {
    static constexpr bool PERM = false;
    bf16* O; const float* ssq; const float2* cs32;
    __device__ __forceinline__ void operator()(const pg8::f32x4 (&acc)[2][2][4][2], const pg8::Unit& u, int wr, int wc, int fr, int fq) const {
        const int row0 = u.pm * 256 + wr * 64 + fr; const float qs = 0.10206207261596577f * LOG2E;
        float scv[2][4];
#pragma unroll
        for (int ai = 0; ai < 2; ++ai) {
            pg8::f32x4 sa[4], sb[4], sc3[4];
#pragma unroll
            for (int m = 0; m < 4; ++m) { const float* sp = ssq + (size_t)(row0 + ai * 128 + m * 16) * 20; sa[m] = *(const pg8::f32x4*)sp; sb[m] = *(const pg8::f32x4*)(sp + 4); sc3[m] = *(const pg8::f32x4*)(sp + 8); }
            __builtin_amdgcn_sched_barrier(0);
#pragma unroll
            for (int m = 0; m < 4; ++m) {
                const float sq = ((sa[m][0] + sa[m][1]) + (sa[m][2] + sa[m][3])) + ((sb[m][0] + sb[m][1]) + (sb[m][2] + sb[m][3])) + ((sc3[m][0] + sc3[m][1]) + (sc3[m][2] + sc3[m][3]));
                scv[ai][m] = rsqrtf(sq * (1.0f / 384.0f) + EPS) * qs;
            }
        }
#pragma unroll
        for (int bj = 0; bj < 2; ++bj) {
            const int G32 = u.pn * 8 + bj * 4 + wc, col0 = G32 * 32 + 4 * fq;
            if (G32 >= 18) continue;
            const bool rope = (G32 % 3) == 2;
#pragma unroll
            for (int ai = 0; ai < 2; ++ai) {
                pg8::f32x4 ca[4][2];
                if (rope) {
#pragma unroll
                    for (int m = 0; m < 4; ++m) { const float2* cs = cs32 + ((row0 + ai * 128 + m * 16) % S) * 16 + 4 * fq; ca[m][0] = *(const pg8::f32x4*)cs; ca[m][1] = *(const pg8::f32x4*)(cs + 2); }
                    __builtin_amdgcn_sched_barrier(0);
                }
#pragma unroll
                for (int m = 0; m < 4; ++m) {
                    const int row = row0 + ai * 128 + m * 16; const float sc = scv[ai][m];
                    pg8::f32x4 v0 = acc[ai][bj][m][0] * sc, v1 = acc[ai][bj][m][1] * sc;
                    if (rope) {
#pragma unroll
                        for (int j = 0; j < 4; ++j) { const float cx = ca[m][j >> 1][2 * (j & 1)], cy = ca[m][j >> 1][2 * (j & 1) + 1]; const float x1 = v0[j], x2 = v1[j]; v0[j] = x1 * cx - x2 * cy; v1[j] = x2 * cx + x1 * cy; } }
                    bf16* rowp = O + (size_t)row * 576 + col0;
                    v2u w0, w1; w0.x = pk2(v0[0], v0[1]); w0.y = pk2(v0[2], v0[3]); w1.x = pk2(v1[0], v1[1]); w1.y = pk2(v1[2], v1[3]);
                    *(v2u*)rowp = w0; *(v2u*)(rowp + 16) = w1;
                }
                asm volatile("" ::: "memory");
            }
        }
    }
};
struct EpiKV {
    static constexpr bool PERM = true;
    bf16* O; const float* ssq;
    __device__ __forceinline__ void operator()(const pg8::f32x4 (&acc)[2][2][4][2], const pg8::Unit& u, int wr, int wc, int fr, int fq) const {
        const int row0 = u.pm * 256 + wr * 64 + fr, col0 = u.pn * 256 + wc * 32 + 8 * fq;
        float scv[2][4];
        {
            pg8::f32x4 sa[2][4], sb[2][4];
#pragma unroll
            for (int ai = 0; ai < 2; ++ai)
#pragma unroll
                for (int m = 0; m < 4; ++m) { const float* sp = ssq + (size_t)(row0 + ai * 128 + m * 16) * 20 + 12; sa[ai][m] = *(const pg8::f32x4*)sp; sb[ai][m] = *(const pg8::f32x4*)(sp + 4); }
            __builtin_amdgcn_sched_barrier(0);
#pragma unroll
            for (int ai = 0; ai < 2; ++ai)
#pragma unroll
                for (int m = 0; m < 4; ++m) scv[ai][m] = rsqrtf((((sa[ai][m][0] + sa[ai][m][1]) + (sa[ai][m][2] + sa[ai][m][3])) + ((sb[ai][m][0] + sb[ai][m][1]) + (sb[ai][m][2] + sb[ai][m][3]))) * (1.0f / 256.0f) + EPS);
        }
#pragma unroll
        for (int ai = 0; ai < 2; ++ai)
#pragma unroll
            for (int m = 0; m < 4; ++m) {
                const int row = row0 + ai * 128 + m * 16; const float sc = scv[ai][m];
                bf16* rowp = O + (size_t)row * 768 + col0;
#pragma unroll
                for (int bj = 0; bj < 2; ++bj) { const pg8::f32x4 v0 = acc[ai][bj][m][0] * sc, v1 = acc[ai][bj][m][1] * sc;
                    v4u w; w.x = pk2(v0[0], v0[1]); w.y = pk2(v0[2], v0[3]); w.z = pk2(v1[0], v1[1]); w.w = pk2(v1[2], v1[3]);
                    *(v4u*)(rowp + bj * 128) = w; }
            }
        asm volatile("" ::: "memory");
    }
};
__device__ __forceinline__ void p1b_q(const Frame& F, AP a, int l) {
    const float* ssq = (const float*)(a->ws + WS_SSQP);
    unsigned char* wl = a->ws + WS_WSMALL + (size_t)l * WSM_LAYER;
    pg8::Gemm g{(const pg8::bf16_t*)(a->ws + WS_U), (const pg8::bf16_t*)(wl + WSM_UQ), 2048, 384, 384};
    DenseOrder S_{T / 256, 3, F.G, F.vcu, g.Bt, 384};
    EpiQ E{(bf16*)(a->ws + WS_QM), ssq, (const float2*)(a->ws + WS_CS32)};
    pg8::gemm_phase<EpiQ, DenseOrder, true>(F.lds, g, S_, E, F.wave, F_LANE);
}
__device__ __forceinline__ void p1b_kv(const Frame& F, AP a, int l) {
    const float* ssq = (const float*)(a->ws + WS_SSQP);
    unsigned char* wl = a->ws + WS_WSMALL + (size_t)l * WSM_LAYER;
    pg8::Gemm g{(const pg8::bf16_t*)(a->ws + WS_U) + 384, (const pg8::bf16_t*)(wl + WSM_UKV), 2048, 256, 256};
    DenseOrder S_{T / 256, 3, F.G, (F.vcu + 64) % F.G, g.Bt, 256};
    EpiKV E{(bf16*)(a->ws + WS_KVM), ssq};
    pg8::gemm_phase<EpiKV, DenseOrder, true>(F.lds, g, S_, E, F.wave, F_LANE);
    asm volatile("s_waitcnt vmcnt(0)" ::: "memory");
    __syncthreads();
    if (F.wave == 0 && F_LANE == 0) {
        __builtin_amdgcn_fence(__ATOMIC_RELEASE, "agent");
        asm volatile("s_waitcnt vmcnt(0)" ::: "memory");
        __hip_atomic_fetch_add((unsigned*)(a->ws + WS_CTL + CTL_ATTQ) + l * 256 + 192, 1u, __ATOMIC_RELAXED, __HIP_MEMORY_SCOPE_AGENT);
    }
}

__device__ __forceinline__ void attn_phase(const Frame& F, AP a, int l) {
    const bf16* U = (const bf16*)(a->ws + WS_U); bf16* Oc = (bf16*)(a->ws + WS_XB);
    const float lambda_init = __uint_as_float((l == 0) ? 0x3e4ccccdu : 0x3eb60549u);
    const float omli_ = __uint_as_float((l == 0) ? 0x3f4ccccdu : 0x3f24fd5cu);
    float d1 = 0.f, d2 = 0.f;
    for (int i = 0; i < 32; ++i) { d1 += a->in[8][l * 32 + i] * a->in[9][l * 32 + i]; d2 += a->in[10][l * 32 + i] * a->in[11][l * 32 + i]; }
    const float lam = expf(d1) - expf(d2) + lambda_init;
    const int nd = NB * 32, nm = NB * 48, nsw = NB * 48;
    const int lane = F_LANE;
    unsigned* ctr = (unsigned*)(a->ws + WS_CTL + CTL_ATTQ) + l * 256;
    volatile LAS unsigned* slot = (volatile LAS unsigned*)(F.lds + LDS_MISC);
#define ATT_NEXT(q, u) do { if (F.wave == 0 && lane == 0) slot[0] = __hip_atomic_fetch_add(ctr + 64 * (q), 1u, __ATOMIC_RELAXED, __HIP_MEMORY_SCOPE_AGENT); \
        __syncthreads(); u = (int)slot[0]; __syncthreads(); } while (0)
    if ((F.vcu % CONV_MOD) == 0) {
#pragma unroll 1
        for (;;) { int u; if (F.wave == 0 && lane == 0) slot[0] = __hip_atomic_fetch_add(ctr + 32, 1u, __ATOMIC_RELAXED, __HIP_MEMORY_SCOPE_AGENT);
            __syncthreads(); u = (int)slot[0]; __syncthreads(); if (u >= CONV_CHUNKS + (l == 0 ? P0_REST_CHUNKS : 0)) break;
            if (u < CONV_CHUNKS) conv_chunk(F, a, l, u); else p0_rest_chunk(F, a, u - CONV_CHUNKS); }
    }
    {
        const att::AttnP pd{U, 2048, 1280, 64, U, 2048, 1536, 64, 1, nullptr, 0, U, 2048, 1792, 64, 1, Oc, D, 768, 64, nullptr, lam, omli_, a->in[12] + l * 64, seam_ctr(a->ws, l, 1, 0)};
#pragma unroll 1
        for (;;) { int u; ATT_NEXT(0, u); if (u >= nd) break; att::attn_unit<2>(pd, u / 32, (u % 32) / 8, u % 8, (att::ldsp)F.lds, F.wave, lane); }
    }
    {
        if (F.wave == 0 && lane == 0) {
            unsigned sp = 0;
            while (__hip_atomic_load(ctr + 192, __ATOMIC_RELAXED, __HIP_MEMORY_SCOPE_AGENT) < (unsigned)F.G) { __builtin_amdgcn_s_sleep(2); if (++sp > (1u << 24)) break; }
            __builtin_amdgcn_fence(__ATOMIC_ACQUIRE, "agent");
            asm volatile("s_waitcnt vmcnt(0)" ::: "memory");
        }
        __syncthreads();
    }
    {
        const att::AttnP pm{(const bf16*)(a->ws + WS_QM), 576, 0, 96, (const bf16*)(a->ws + WS_KVM), 768, 0, 128, 1, (const bf16*)(a->ws + WS_KROPE), 32, (const bf16*)(a->ws + WS_KVM), 768, 64, 128, 1, Oc, D, 0, 64, nullptr, 0.f, 0.f, nullptr, seam_ctr(a->ws, l, 1, 0)};
#pragma unroll 1
        for (;;) { int u; ATT_NEXT(1, u); if (u >= nm) break; att::attn_unit<0>(pm, u / 48, (u % 48) / 8, u % 8, (att::ldsp)F.lds, F.wave, lane); }
    }
    {
        const att::AttnP ps{U, 2048, 640, 64, U, 2048, 1024, 64, 3, nullptr, 0, U, 2048, 1152, 64, 3, Oc, D, 384, 64, a->in[7] + l * 6, 0.f, 0.f, nullptr, seam_ctr(a->ws, l, 1, 0)};
#pragma unroll 1
        for (;;) { int u; ATT_NEXT(2, u); if (u >= nsw) break; att::attn_unit<1>(ps, u / 48, (u % 48) / 8, u % 8, (att::ldsp)F.lds, F.wave, lane); }
    }
#undef ATT_NEXT
}

#ifndef EPIRES_ROWS
#define EPIRES_ROWS 2
#endif
struct EpiRes {
    static constexpr bool PERM = false;
    const float* res; float* O;
    __device__ __forceinline__ void operator()(const pg8::f32x4 (&acc)[2][2][4][2], const pg8::Unit& u, int wr, int wc, int fr, int fq) const {
        const int row0 = u.pm * 256 + wr * 64 + fr, col0 = u.pn * 256 + wc * 32 + 4 * fq;
#pragma unroll
        for (int ai = 0; ai < 2; ++ai)
#pragma unroll
            for (int mp = 0; mp < 4; mp += EPIRES_ROWS) {
                pg8::f32x4 r[EPIRES_ROWS][2][2];
#pragma unroll
                for (int m = 0; m < EPIRES_ROWS; ++m)
#pragma unroll
                    for (int bj = 0; bj < 2; ++bj)
#pragma unroll
                        for (int n = 0; n < 2; ++n) r[m][bj][n] = *(const pg8::f32x4*)(res + (size_t)(row0 + ai * 128 + (mp + m) * 16) * D + col0 + bj * 128 + n * 16);
                __builtin_amdgcn_sched_barrier(0);
#pragma unroll
                for (int m = 0; m < EPIRES_ROWS; ++m)
#pragma unroll
                    for (int bj = 0; bj < 2; ++bj)
#pragma unroll
                        for (int n = 0; n < 2; ++n) *(pg8::f32x4*)(O + (size_t)(row0 + ai * 128 + (mp + m) * 16) * D + col0 + bj * 128 + n * 16) = r[m][bj][n] + acc[ai][bj][mp + m][n];
                asm volatile("" ::: "memory");
            }
    }
};
__device__ __forceinline__ void p3_outproj(const Frame& F, AP a, int l) {
    pg8::Gemm g{(const pg8::bf16_t*)(a->ws + WS_XB), (const pg8::bf16_t*)(a->ws + WS_WSMALL + (size_t)l * WSM_LAYER + WSM_OUT), 1024, 1024, 1024};
    DenseOrder S_{T / 256, 4, F.G, F.vcu, g.Bt, 1024};
    EpiRes E{l == 0 ? a->in[0] : (const float*)(a->ws + WS_XA), (float*)(a->ws + WS_XA)};
    seam_wait(F, seam_ctr(a->ws, l, 1, F.vcu / 4), 128u);
    pg8::gemm_phase<EpiRes, DenseOrder, true>(F.lds, g, S_, E, F.wave, F_LANE);
    seam_publish(F, seam_ctr(a->ws, l, 0, F.vcu / 4));
}

struct MoeOrder {
    int nN, G, c; const LAS int* tstart; const int* cnt; const int* list; const pg8::bf16_t* Bt; int ldb; size_t estride; int shift;
    __device__ __forceinline__ bool next(int i, pg8::Unit& u) const {
        const int L = i * G + c, tau = L / nN; if (tau >= tstart[32]) return false;
        int e = 0;
#pragma unroll 1
        for (int k = 16; k >= 1; k >>= 1) if (tstart[e + k] <= tau) e += k;
        u.e = e; u.pm = tau - tstart[e]; u.pn = L % nN; u.cnt = cnt[e] - u.pm * 256; u.tau = tau; return true;
    }
    __device__ __forceinline__ unsigned arow(const pg8::Unit& u, int r) const { const int rr = r < u.cnt ? r : 0; return (unsigned)(list[(size_t)u.e * LCAP + u.pm * 256 + rr] >> shift); }
    __device__ __forceinline__ const pg8::bf16_t* bbase(const pg8::Unit& u) const { return Bt + (size_t)u.e * estride + (size_t)u.pn * 256 * ldb; }
};
struct MoeQueue {
    int nN; const LAS int* tstart; const int* cnt; const int* list; const pg8::bf16_t* Bt; int ldb; size_t estride;
    unsigned* ctr; unsigned* tdone; volatile LAS int* slot; int wave, lane;
    __device__ __forceinline__ bool next(int i, pg8::Unit& u) const {
        if (wave == 0 && lane == 0) {
            const int L = (int)__hip_atomic_fetch_add(ctr, 1u, __ATOMIC_RELAXED, __HIP_MEMORY_SCOPE_AGENT);
            const int tau = L / nN;
            if (tau < tstart[32]) {
                unsigned sp = 0;
                while (__hip_atomic_load(tdone + tau, __ATOMIC_RELAXED, __HIP_MEMORY_SCOPE_AGENT) < 16u) { __builtin_amdgcn_s_sleep(2); if (++sp > (1u << 24)) break; }
                __builtin_amdgcn_fence(__ATOMIC_ACQUIRE, "agent");
                asm volatile("s_waitcnt vmcnt(0)" ::: "memory");
            }
            slot[i & 1] = L;
        }
        asm volatile("s_waitcnt lgkmcnt(0)\n\ts_barrier" ::: "memory");
        const int L = slot[i & 1], tau = L / nN; if (tau >= tstart[32]) return false;
        int e = 0;
#pragma unroll 1
        for (int k = 16; k >= 1; k >>= 1) if (tstart[e + k] <= tau) e += k;
        u.e = e; u.pm = tau - tstart[e]; u.pn = L % nN; u.cnt = cnt[e] - u.pm * 256; u.tau = tau; return true;
    }
    __device__ __forceinline__ unsigned arow(const pg8::Unit& u, int r) const { const int rr = r < u.cnt ? r : 0; return (unsigned)list[(size_t)u.e * LCAP + u.pm * 256 + rr]; }
    __device__ __forceinline__ const pg8::bf16_t* bbase(const pg8::Unit& u) const { return Bt + (size_t)u.e * estride + (size_t)u.pn * 256 * ldb; }
};
struct EpiGU {
    static constexpr bool PERM = false;
    bf16* hid; const float* rF; const float* slot_w; const int* list; unsigned* tdone;
    __device__ __forceinline__ void operator()(const pg8::f32x4 (&acc)[2][2][4][2], const pg8::Unit& u, int wr, int wc, int fr, int fq) const {
        const int* lp = list + (size_t)u.e * LCAP + u.pm * 256;
        int slot[2][4]; float rfv[2][4], wv[2][4];
#pragma unroll
        for (int ai = 0; ai < 2; ++ai)
#pragma unroll
            for (int m = 0; m < 4; ++m) { const int r = ai * 128 + wr * 64 + m * 16 + fr; slot[ai][m] = lp[r < u.cnt ? r : 0]; }
#pragma unroll
        for (int ai = 0; ai < 2; ++ai)
#pragma unroll
            for (int m = 0; m < 4; ++m) { rfv[ai][m] = rF[slot[ai][m] >> 1]; wv[ai][m] = slot_w[slot[ai][m]]; }
        __builtin_amdgcn_sched_barrier(0);
#pragma unroll
        for (int ai = 0; ai < 2; ++ai)
#pragma unroll
            for (int m = 0; m < 4; ++m) {
                const int r = ai * 128 + wr * 64 + m * 16 + fr;
                if (r < u.cnt) {
                    const float rf = rfv[ai][m], w = wv[ai][m];
                    bf16* rowp = hid + (size_t)slot[ai][m] * 256 + u.pn * 128 + wc * 16 + 4 * fq;
#pragma unroll
                    for (int bj = 0; bj < 2; ++bj) {
                        float h[4];
#pragma unroll
                        for (int j = 0; j < 4; ++j) { const float av = acc[ai][bj][m][0][j] * rf, uv = acc[ai][bj][m][1][j] * rf; h[j] = av / (1.0f + __expf(-av)) * uv * w; }
                        const unsigned long long o = (unsigned long long)pk2(h[0], h[1]) | ((unsigned long long)pk2(h[2], h[3]) << 32);
                        __hip_atomic_store((unsigned long long*)(rowp + bj * 64), o, __ATOMIC_RELAXED, __HIP_MEMORY_SCOPE_AGENT);
                    }
                }
            }
        asm volatile("s_waitcnt vmcnt(0)" ::: "memory");
        if (fr == 0 && fq == 0) __hip_atomic_fetch_add(tdone + u.tau, 1u, __ATOMIC_RELAXED, __HIP_MEMORY_SCOPE_AGENT);
    }
};
#ifndef EPIDOWN_ROWS
#define EPIDOWN_ROWS 4
#endif
struct EpiDown {
    static constexpr bool PERM = true;
    bf16* y; const int* list;
    __device__ __forceinline__ void operator()(const pg8::f32x4 (&acc)[2][2][4][2], const pg8::Unit& u, int wr, int wc, int fr, int fq) const {
        const int* lp = list + (size_t)u.e * LCAP + u.pm * 256 + wr * 64 + fr; const int col0 = u.pn * 256 + wc * 32 + 8 * fq; const int cnt = u.cnt - (wr * 64 + fr);
#pragma unroll
        for (int ai = 0; ai < 2; ++ai)
#pragma unroll
            for (int mp = 0; mp < 4; mp += EPIDOWN_ROWS) {
                int slot[EPIDOWN_ROWS];
#pragma unroll
                for (int m = 0; m < EPIDOWN_ROWS; ++m) { const int r = ai * 128 + (mp + m) * 16; slot[m] = (r < cnt) ? lp[r] : 0; }
                __builtin_amdgcn_sched_barrier(0);
#pragma unroll
                for (int m = 0; m < EPIDOWN_ROWS; ++m) {
                    const int r = ai * 128 + (mp + m) * 16;
                    if (r < cnt) {
                        bf16* rowp = y + (size_t)slot[m] * D + col0;
#pragma unroll
                        for (int bj = 0; bj < 2; ++bj) { const pg8::f32x4 v0 = acc[ai][bj][mp + m][0], v1 = acc[ai][bj][mp + m][1];
                            v4u w; w.x = pk2(v0[0], v0[1]); w.y = pk2(v0[2], v0[3]); w.z = pk2(v1[0], v1[1]); w.w = pk2(v1[2], v1[3]);
                            *(v4u*)(rowp + bj * 128) = w; }
                    }
                }
                asm volatile("" ::: "memory");
            }
    }
};
__device__ __forceinline__ void moe_tiles(const Frame& F, const int* cnt) {
    LAS int* tstart = (LAS int*)(F.lds + LDS_MISC);
    if (F_TID == 0) { int acc = 0; for (int e = 0; e < 32; ++e) { tstart[e] = acc; acc += (cnt[e] + 255) >> 8; } tstart[32] = acc; }
    __syncthreads();
}
__device__ __forceinline__ void moe_gateup(const Frame& F, AP a, int l) {
    const int* cnt = (const int*)(a->ws + WS_CTL + CTL_CNT) + l * 32; const int* list = (const int*)(a->ws + WS_LIST);
    moe_tiles(F, cnt);
    pg8::Gemm g{(const pg8::bf16_t*)(a->ws + WS_XB), (const pg8::bf16_t*)(a->ws + WS_WGU), 1024, 1024, 1024};
    MoeOrder S_{2, F.G, F.vcu, (const LAS int*)(F.lds + LDS_MISC), cnt, list, g.Bt, 1024, (size_t)512 * 1024, 1};
    EpiGU E{(bf16*)(a->ws + WS_QM), (const float*)(a->ws + WS_RF), (const float*)(a->ws + WS_SLOTW), list, (unsigned*)(a->ws + WS_CTL + CTL_MOEQ) + l * 1024 + 64};
    pg8::gemm_phase<EpiGU, MoeOrder, true>(F.lds, g, S_, E, F.wave, F_LANE);
}
__device__ __forceinline__ void moe_down(const Frame& F, AP a, int l) {
    const int* cnt = (const int*)(a->ws + WS_CTL + CTL_CNT) + l * 32; const int* list = (const int*)(a->ws + WS_LIST);
    moe_tiles(F, cnt);
    pg8::Gemm g{(const pg8::bf16_t*)(a->ws + WS_QM), (const pg8::bf16_t*)(a->ws + WS_WD), 256, 256, 256};
    unsigned* q = (unsigned*)(a->ws + WS_CTL + CTL_MOEQ) + l * 1024;
    MoeQueue S_{4, (const LAS int*)(F.lds + LDS_MISC), cnt, list, g.Bt, 256, (size_t)1024 * 256, q, q + 64, (volatile LAS int*)(F.lds + LDS_MISC + 1024), F.wave, F_LANE};
    EpiDown E{(bf16*)(a->ws + WS_U), list};
    pg8::gemm_phase<EpiDown, MoeQueue, true>(F.lds, g, S_, E, F.wave, F_LANE);
}

__device__ __forceinline__ void run_phase(const Frame& F0, AP ap, int ph, int l, int rr = 0) {
    AP args = launder(ap);
    Frame F = F0;
    { int wv = F0.wave, vc = F0.vcu; asm volatile("" : "+s"(wv), "+s"(vc)); F.wave = wv; F.vcu = vc; }
    { int ln = lane_id(); asm volatile("" : "+v"(ln)); F.lane = ln; }
    switch (ph) {
        case 0: p0_small(F, args); break;
        case 1: p0_experts(F, args, l); break;
        case 2: light_pass<0>(F, args, l); break;
        case 3: p1_gemm(F, args, l); break;
        case 4: p1b_q(F, args, l); break;
        case 12: p1b_kv(F, args, l); break;
        case 5: attn_phase(F, args, l); break;
        case 6: p3_outproj(F, args, l); break;
        case 7: light_pass<3>(F, args, l, rr); break;
        case 8: moe_gateup(F, args, l); break;
        case 9: moe_down(F, args, l); break;
        case 10: light_pass<1>(F, args, l); break;
        case 11: norm_pass<2>(F, args, l); break;
        default: break;
    }
}
#ifndef USE_CG
#define USE_CG 0
#endif
typedef GAS unsigned gu32;
#define XB_TMO      128
#define XB_XCNT(j)  (256  + 64 * (j))
#define XB_XSUB(j)  (1280 + 64 * (j))
#define XB_XGEN(j)  (2304 + 64 * (j))
#define XB_TOP      3328
#define XB_TOPGEN   3392
#define XCD_BAR_WORDS 3456
#define XB_SPIN_CAP (1u << 22)
__device__ __forceinline__ unsigned xb_ld(unsigned* p)              { return __hip_atomic_load(p, __ATOMIC_RELAXED, __HIP_MEMORY_SCOPE_AGENT); }
__device__ __forceinline__ unsigned xb_add(unsigned* p, unsigned v) { return __hip_atomic_fetch_add(p, v, __ATOMIC_RELAXED, __HIP_MEMORY_SCOPE_AGENT); }
__device__ __forceinline__ unsigned xb_xcc_id() { return (unsigned)__builtin_amdgcn_s_getreg((3 << 11) | 20) & 0xFu; }
#define XB_SPIN(cond, bar) do { unsigned _sp = 0; while (cond) { __builtin_amdgcn_s_sleep(1); \
    if ((++_sp & 255u) == 0u) { if (xb_ld(&(bar)[XB_TMO])) break; if (_sp > XB_SPIN_CAP) { atomicAdd(&(bar)[XB_TMO], 1u); break; } } } } while (0)
struct XcdBarrier { unsigned* bar; unsigned x; volatile LAS unsigned* st; };
__device__ __forceinline__ XcdBarrier xcd_barrier_post(unsigned* bar, volatile LAS unsigned* st) {
    XcdBarrier b; b.bar = bar; b.x = xb_xcc_id(); b.st = st;
    if (threadIdx.x == 0) (void)xb_add(&bar[XB_XCNT(b.x)], 1u);
    return b;
}
__device__ __forceinline__ void xcd_barrier_complete(unsigned* bar, unsigned x, unsigned& nloc, unsigned& nx) {
    const unsigned G = gridDim.x * gridDim.y * gridDim.z;
    unsigned sum, cnt, mine, sp = 0u;
    for (;;) {
        sum = 0u; cnt = 0u; mine = 0u;
#pragma unroll
        for (unsigned j = 0; j < 16; ++j) { const unsigned c = xb_ld(&bar[XB_XCNT(j)]); sum += c; cnt += (c > 0u) ? 1u : 0u; mine = (j == x) ? c : mine; }
        if (sum == G) break;
        __builtin_amdgcn_s_sleep(1);
        if ((++sp & 255u) == 0u) { if (xb_ld(&bar[XB_TMO])) break; if (sp > XB_SPIN_CAP) { atomicAdd(&bar[XB_TMO], 1u); break; } }
    }
    nloc = mine > 0u ? mine : 1u; nx = cnt > 0u ? cnt : 1u;
}
__device__ __forceinline__ void xcd_barrier(const XcdBarrier& b, int wave) {
    asm volatile("s_waitcnt vmcnt(0)" ::: "memory");
    __syncthreads();
    int ln = lane_id(); asm volatile("" : "+v"(ln));
    if (wave == 0 && ln == 0) {
        unsigned* bar = b.bar;
        __builtin_amdgcn_s_waitcnt(0);
        unsigned nloc = b.st[0], nx = b.st[1];
        if (nloc == 0u) { xcd_barrier_complete(bar, b.x, nloc, nx); b.st[0] = nloc; b.st[1] = nx; }
        const unsigned old = xb_add(&bar[XB_XSUB(b.x)], 1u);
        const unsigned gen = old / nloc;
        if (old + 1u == (gen + 1u) * nloc) {
            __builtin_amdgcn_fence(__ATOMIC_RELEASE, "agent");
            asm volatile("s_waitcnt vmcnt(0)" ::: "memory");
            const unsigned og = xb_add(&bar[XB_TOP], 1u);
            const unsigned tg = og / nx;
            if (og + 1u == (tg + 1u) * nx) xb_add(&bar[XB_TOPGEN], 1u);
            else XB_SPIN(xb_ld(&bar[XB_TOPGEN]) == tg, bar);
            __builtin_amdgcn_fence(__ATOMIC_ACQUIRE, "agent");
            xb_add(&bar[XB_XGEN(b.x)], 1u);
            asm volatile("s_waitcnt vmcnt(0)" ::: "memory");
        } else {
            XB_SPIN(xb_ld(&bar[XB_XGEN(b.x)]) == gen, bar);
            __builtin_amdgcn_fence(__ATOMIC_ACQUIRE, "agent");
            asm volatile("s_waitcnt vmcnt(0)" ::: "memory");
        }
    }
    __syncthreads();
}
__device__ __forceinline__ void grid_sync(const XcdBarrier& b, int wave) {
#if USE_CG
    cooperative_groups::this_grid().sync();
#else
    xcd_barrier(b, wave);
#endif
}
constexpr unsigned long long LSEQ = 0x98765C43ull; constexpr int LSTEPS = 8; constexpr unsigned LBAR = 0xA1;
__global__ void __launch_bounds__(NWAVES * 64, 2) mega(Args args_unused) {
    extern __shared__ __attribute__((aligned(16))) unsigned char lds[];
    AP ap = (AP)__builtin_amdgcn_kernarg_segment_ptr();
    Frame F;
    F.lds = (LAS unsigned char*)lds;
    F.wave = __builtin_amdgcn_readfirstlane((int)threadIdx.x >> 6); F.lane = 0;
    F.G = gridDim.x; { const int bx = blockIdx.x; F.vcu = (F.G % 8 == 0) ? (bx % 8) * (F.G / 8) + bx / 8 : bx; }
    const int ph0 = ap->phase;
    volatile LAS unsigned* bst = (volatile LAS unsigned*)(lds + LDS_MISC + 8192);
    if (threadIdx.x < 2) bst[threadIdx.x] = 0u;
    __syncthreads();
    XcdBarrier xb; xb.bar = (unsigned*)(ap->ws + WS_CTL + CTL_BAR); xb.x = 0; xb.st = bst;
    if (ph0 < 0 && !USE_CG) xb = xcd_barrier_post((unsigned*)(ap->ws + WS_CTL + CTL_BAR), bst);
    const int npc = ph0 >= 0 ? 1 : 2 + NL * (LSTEPS + 1);
#pragma unroll 1
    for (int pc = 0; pc < npc; ++pc) {
        int ph, l, bar;
        if (ph0 >= 0) { ph = ph0; l = ap->layer; bar = 0; }
        else if (pc == 0) { ph = 0; l = 0; bar = 0; }
        else if (pc == 1) { ph = 2; l = 0; bar = 1; }
        else {
            const int q = pc - 2, s = q % (LSTEPS + 1); l = q / (LSTEPS + 1);
            if (s < LSTEPS) { ph = (int)((LSEQ >> (4 * s)) & 15ull); bar = (int)((LBAR >> s) & 1u); }
            else if (l + 1 < NL) { ph = 10; l = l + 1; bar = 1; }
            else { ph = 11; bar = 0; }
        }
        const int extra = ((ap->rep >> ph) & 1) && (l == 0 || !((ap->rep >> 29) & 1));
#pragma unroll 1
        for (int rr = 0; rr <= extra; ++rr) {
            run_phase(F, ap, ph, l, rr);
            if (rr < extra) grid_sync(xb, F.wave);
        }
        if (bar) { grid_sync(xb, F.wave); if ((ap->rep >> 30) & 1) { grid_sync(xb, F.wave); grid_sync(xb, F.wave); } } else __syncthreads();
    }
}
#ifndef REPMASK
#define REPMASK 0
#endif
extern "C" void kernel_launch(void* const* d_in, const int* in_sizes, int n_in, void* d_out, int out_size, void* d_ws, size_t ws_size, hipStream_t stream) {
    static int grid = 0;
    if (grid == 0) {
        int dev = 0, cus = 0, per_cu = 0;
        hipGetDevice(&dev); hipDeviceGetAttribute(&cus, hipDeviceAttributeMultiprocessorCount, dev);
        (void)hipFuncSetAttribute((const void*)mega, hipFuncAttributeMaxDynamicSharedMemorySize, LDS_BYTES);
        (void)hipOccupancyMaxActiveBlocksPerMultiprocessor(&per_cu, (const void*)mega, NWAVES * 64, LDS_BYTES);
        if (n_in != 23 || ws_size < WS_END || cus < 256 || per_cu < 1) { fprintf(stderr, "kernel_launch: unexpected configuration (n_in %d, ws %zu, CUs %d, blocks/CU %d)\n", n_in, ws_size, cus, per_cu); grid = -1; return; }
        grid = 256;
    }
    if (grid < 0) return;
    (void)hipMemsetAsync((char*)d_ws + WS_CTL, 0, CTL_BYTES, stream);
    Args a{};
    for (int i = 0; i < 23; ++i) a.in[i] = (const float*)d_in[i];
    a.out = (float*)d_out; a.ws = (unsigned char*)d_ws; a.phase = -1; a.layer = 0; a.rep = REPMASK;
    void* kargs[] = {&a};
    hipError_t e = hipLaunchCooperativeKernel((const void*)mega, dim3(grid), dim3(NWAVES * 64), kargs, LDS_BYTES, stream);
    if (e != hipSuccess) fprintf(stderr, "kernel_launch: cooperative launch failed: %s\n", hipGetErrorString(e));
}
```

```cpp
#include <hip/hip_runtime.h>
#include <math.h>
#include <stdint.h>
#include <cstdio>
#include <hip/hip_cooperative_groups.h>
constexpr int D = 1024, NB = 8, S = 2048, T = NB * S, INW = 2080, NL = 2;
constexpr int NE = 32, FF = 256;
constexpr float EPS = 1e-6f;

__device__ __forceinline__ float wave_sum(float v) {
#pragma unroll
    for (int o = 32; o >= 1; o >>= 1) v += __shfl_xor(v, o);
    return v;
}
__device__ __forceinline__ float wave_max(float v) {
#pragma unroll
    for (int o = 32; o >= 1; o >>= 1) v = fmaxf(v, __shfl_xor(v, o));
    return v;
}
namespace pg8 {
#define PG8_LAS __attribute__((address_space(3)))
typedef unsigned short bf16_t;
typedef short bf16x8 __attribute__((ext_vector_type(8)));
typedef float f32x4 __attribute__((ext_vector_type(4)));
typedef unsigned u32x4 __attribute__((ext_vector_type(4)));
typedef unsigned u32x2 __attribute__((ext_vector_type(2)));
constexpr int BM = 256, BK = 64, HALF = 128, HTB = HALF * BK * 2  , STAGE_BYTES = 8 * HTB;

__device__ __forceinline__ int lds_byte(int r, int c) { const int st = (r >> 4) * 2 + (c >> 5), rr = r & 15, cc = c & 31, ob = rr * 64 + cc * 2; return st * 1024 + (ob ^ (((ob >> 9) & 1) << 5)); }
__device__ __forceinline__ void stage_rc(int b, int& R, int& C) { const int st = b / 1024, sb = b % 1024, swz = sb ^ (((sb >> 9) & 1) << 5); R = (st >> 1) * 16 + swz / 64; C = (st & 1) * 32 + (swz % 64) / 2; }
__device__ __forceinline__ int perm32(int rho) { const int n = rho >> 4, i = rho & 15; return 8 * (i >> 2) + 4 * n + (i & 3); }

struct Unit { int pm, pn, e, cnt, tau; };
struct Gemm { const bf16_t* A; const bf16_t* Bt; int lda, ldb, K; };

__device__ __forceinline__ unsigned cvt_pk_bf16(float lo, float hi) {
    typedef float f2 __attribute__((ext_vector_type(2))); typedef __bf16 b2 __attribute__((ext_vector_type(2)));
    f2 v = {lo, hi}; b2 b = __builtin_convertvector(v, b2); return __builtin_bit_cast(unsigned, b);
}

__device__ __forceinline__ void stage2(PG8_LAS unsigned char* lds, int bufoff, unsigned ldsw, const char* gbase, const unsigned (&voff)[2], size_t kb) {
#pragma unroll
    for (int i = 0; i < 2; ++i)
        __builtin_amdgcn_global_load_lds((const unsigned*)(gbase + voff[i] + kb), (PG8_LAS unsigned*)(lds + bufoff + ldsw + i * 8192), 16, 0, 0);
}

template <class Epi, class Sched, bool ALIGN_EPI>
__device__ __forceinline__ void gemm_phase(PG8_LAS unsigned char* lds, const Gemm g, const Sched& S, const Epi& E, const int wid, const int lane) {
    const int tid = wid * 64 + lane, wr = wid >> 2, wc = wid & 3, fr = lane & 15, fq = lane >> 4;
    const int K = g.K, nt = K / BK;
    unsigned voffB[2];
#pragma unroll
    for (int i = 0; i < 2; ++i) { int R, C; stage_rc(tid * 16 + i * 8192, R, C); const int Rb = Epi::PERM ? ((R & ~31) + perm32(R & 31)) : R;
        voffB[i] = (unsigned)(Rb * g.ldb + C) * 2u; }
    const size_t kstep = (size_t)(BK * 2);
    const size_t hstepB = (size_t)HALF * g.ldb * 2;
    const unsigned ldsw = (unsigned)wid * 1024u;
    const int aoff = lds_byte(wr * 64 + fr, fq * 8), boff = lds_byte(wc * 32 + fr, fq * 8);
    const char* Ab = (const char*)g.A;
#define PG8_SA(b, h) (((b) * 2 + (h)) * HTB)
#define PG8_SB(b, h) ((4 + (b) * 2 + (h)) * HTB)
#define PG8_STAGE(bufoff, gbase, voff, kb) stage2(lds, (bufoff), ldsw, (gbase), (voff), (kb))
#define PG8_LDA(dst, b, h) do { _Pragma("unroll") for (int m = 0; m < 4; ++m) _Pragma("unroll") for (int k = 0; k < 2; ++k) dst[m][k] = *(const PG8_LAS bf16x8*)(lds + PG8_SA(b, h) + aoff + m * 2048 + k * 1024); } while (0)
#define PG8_LDB(dst, b, h) do { _Pragma("unroll") for (int n = 0; n < 2; ++n) _Pragma("unroll") for (int k = 0; k < 2; ++k) dst[n][k] = *(const PG8_LAS bf16x8*)(lds + PG8_SB(b, h) + boff + n * 2048 + k * 1024); } while (0)
#define PG8_MMA(ai, bj, At, Bt) do { __builtin_amdgcn_s_setprio(1); _Pragma("unroll") for (int m = 0; m < 4; ++m) _Pragma("unroll") for (int n = 0; n < 2; ++n) _Pragma("unroll") for (int k = 0; k < 2; ++k) \
        acc[ai][bj][m][n] = __builtin_amdgcn_mfma_f32_16x16x32_bf16(Bt[n][k], At[m][k], acc[ai][bj][m][n], 0, 0, 0); __builtin_amdgcn_s_setprio(0); } while (0)
#define PG8_WAIT_V(n) asm volatile("s_waitcnt vmcnt(" #n ")" ::: "memory")
#define PG8_WAIT_L(n) asm volatile("s_waitcnt lgkmcnt(" #n ")" ::: "memory")
#define PG8_BAR __builtin_amdgcn_s_barrier()
#define PG8_SCHED __builtin_amdgcn_sched_barrier(0)
#define PG8_MKOFF(u, d0, d1) do { _Pragma("unroll") for (int _i = 0; _i < 2; ++_i) { int _R, _C; stage_rc(tid * 16 + _i * 8192, _R, _C); d0[_i] = (S.arow(u, _R) * (unsigned)g.lda + (unsigned)_C) * 2u; d1[_i] = (S.arow(u, HALF + _R) * (unsigned)g.lda + (unsigned)_C) * 2u; } } while (0)
    Unit cur, nxt; int ui = 0;
    if (!S.next(0, cur)) return;
    f32x4 acc[2][2][4][2];
#pragma unroll
    for (int a = 0; a < 2; ++a)
#pragma unroll
        for (int b = 0; b < 2; ++b)
#pragma unroll
            for (int m = 0; m < 4; ++m)
#pragma unroll
                for (int n = 0; n < 2; ++n) acc[a][b][m][n] = (f32x4){0.f, 0.f, 0.f, 0.f};
    bf16x8 At[4][2], B0[2][2], B1[2][2];
    unsigned o0[2], o1[2], n0[2], n1[2];
    PG8_MKOFF(cur, o0, o1);
    const char* cB = (const char*)S.bbase(cur);
    PG8_STAGE(PG8_SB(0, 0), cB, voffB, 0); PG8_STAGE(PG8_SB(0, 1), cB + hstepB, voffB, 0); PG8_STAGE(PG8_SA(0, 0), Ab, o0, 0); PG8_STAGE(PG8_SA(0, 1), Ab, o1, 0);
    if (wr == 1) PG8_BAR;
    PG8_WAIT_V(2); PG8_BAR;
    PG8_STAGE(PG8_SB(1, 0), cB, voffB, kstep); PG8_STAGE(PG8_SA(1, 0), Ab, o0, kstep); PG8_STAGE(PG8_SB(1, 1), cB + hstepB, voffB, kstep);
    PG8_WAIT_V(6); PG8_BAR;
    for (;;) {
        const bool has_next = S.next(ui + 1, nxt);
        const char* nB = cB;
        if (has_next) { PG8_MKOFF(nxt, n0, n1); nB = (const char*)S.bbase(nxt); }
        else {
#pragma unroll
            for (int i = 0; i < 2; ++i) { n0[i] = o0[i]; n1[i] = o1[i]; } }
#pragma unroll 1
        for (int t = 0; t < nt; t += 2) {
            const bool last = (t == nt - 2);
            const size_t a1k = (size_t)(t + 1) * kstep;
            unsigned x0[2], x1[2];
#pragma unroll
            for (int i = 0; i < 2; ++i) { x0[i] = last ? n0[i] : o0[i]; x1[i] = last ? n1[i] : o1[i]; }
            const size_t k2 = last ? 0 : (size_t)(t + 2) * kstep, k3 = k2 + kstep;
            const char* b2 = last ? nB : cB;
            PG8_LDB(B0, 0, 0); PG8_LDB(B1, 0, 1); PG8_SCHED; PG8_LDA(At, 0, 0); PG8_STAGE(PG8_SA(1, 1), Ab, o1, a1k);
            PG8_WAIT_V(8); PG8_WAIT_L(0); PG8_BAR; PG8_MMA(0, 0, At, B0); PG8_MMA(0, 1, At, B1); PG8_BAR; PG8_SCHED;
            PG8_LDA(At, 0, 1); PG8_STAGE(PG8_SB(0, 0), b2, voffB, k2); PG8_STAGE(PG8_SB(0, 1), b2 + hstepB, voffB, k2); PG8_STAGE(PG8_SA(0, 0), Ab, x0, k2);
            PG8_WAIT_V(8); PG8_WAIT_L(0); PG8_BAR; PG8_MMA(1, 0, At, B0); PG8_MMA(1, 1, At, B1); PG8_BAR; PG8_SCHED;
            PG8_LDB(B0, 1, 0); PG8_LDB(B1, 1, 1); PG8_SCHED; PG8_LDA(At, 1, 0); PG8_STAGE(PG8_SA(0, 1), Ab, x1, k2);
            PG8_WAIT_V(8); PG8_WAIT_L(0); PG8_BAR; PG8_MMA(0, 0, At, B0); PG8_MMA(0, 1, At, B1); PG8_BAR; PG8_SCHED;
            PG8_LDA(At, 1, 1); PG8_STAGE(PG8_SB(1, 0), b2, voffB, k3); PG8_STAGE(PG8_SB(1, 1), b2 + hstepB, voffB, k3); PG8_STAGE(PG8_SA(1, 0), Ab, x0, k3);
            PG8_WAIT_V(8); PG8_WAIT_L(0); PG8_BAR; PG8_MMA(1, 0, At, B0); PG8_MMA(1, 1, At, B1); PG8_BAR; PG8_SCHED;
        }
        if constexpr (ALIGN_EPI) { if (wr == 0) PG8_BAR; }
        E(acc, cur, wr, wc, fr, fq);
        if (!has_next) break;
#pragma unroll
        for (int a = 0; a < 2; ++a)
#pragma unroll
            for (int b = 0; b < 2; ++b)
#pragma unroll
                for (int m = 0; m < 4; ++m)
#pragma unroll
                    for (int n = 0; n < 2; ++n) acc[a][b][m][n] = (f32x4){0.f, 0.f, 0.f, 0.f};
        cur = nxt; cB = nB; ++ui;
#pragma unroll
        for (int i = 0; i < 2; ++i) { o0[i] = n0[i]; o1[i] = n1[i]; }
        if constexpr (ALIGN_EPI) { if (wr == 1) PG8_BAR; }
    }
    PG8_WAIT_V(0);
    if constexpr (!ALIGN_EPI) { if (wr == 0) PG8_BAR; }
    PG8_BAR;
#undef PG8_SA
#undef PG8_SB
#undef PG8_STAGE
#undef PG8_LDA
#undef PG8_LDB
#undef PG8_MMA
#undef PG8_WAIT_V
#undef PG8_WAIT_L
#undef PG8_BAR
#undef PG8_SCHED
#undef PG8_MKOFF
}
}
namespace att {
typedef short bf16x8 __attribute__((ext_vector_type(8)));
typedef short s16x4 __attribute__((ext_vector_type(4)));
typedef float f32x16 __attribute__((ext_vector_type(16)));
typedef __attribute__((address_space(3))) unsigned char* ldsp;
constexpr int KSLOT = 12288, VSLOT = 8192, K_OFF = 0, V_OFF = 2 * KSLOT, WS_OFF = V_OFF + 2 * VSLOT, OST_OFF = 65536  , ATT_LDS = OST_OFF + 8 * 4096;
constexpr float LOG2E = 1.4426950408889634f;
constexpr float THR = 8.0f;

struct AttnP {
    const unsigned short* Q; int qp, qc, qhs;
    const unsigned short* K; int kp, kc, khs, kgrp;
    const unsigned short* K2; int k2p;
    const unsigned short* V; int vp, vc, vhs, vgrp;
    unsigned short* O; int op, oc, ohs;
    const float* sink;
    float lam, omli; const float* subln;
    unsigned* done;
};

__device__ __forceinline__ int crow(int r, int hi) { return (r & 3) + 8 * (r >> 2) + 4 * hi; }
__device__ __forceinline__ s16x4 vtr(const __attribute__((address_space(3))) unsigned char* p) {
    typedef short v4i16_t __attribute__((ext_vector_type(4)));
    return __builtin_bit_cast(s16x4, __builtin_amdgcn_ds_read_tr16_b64_v4i16((__attribute__((address_space(3))) v4i16_t*)p));
}
__device__ __forceinline__ float max3f(float a, float b, float c) { float r; asm("v_max3_f32 %0, %1, %2, %3" : "=v"(r) : "v"(a), "v"(b), "v"(c)); return r; }
__device__ __forceinline__ float max2f(float a, float b) { float r; asm("v_max_f32_e32 %0, %1, %2" : "=v"(r) : "v"(a), "v"(b)); return r; }
#define ATT_WAIT_BAR() asm volatile("s_waitcnt vmcnt(0) lgkmcnt(0)\n\ts_barrier" ::: "memory")
__device__ __forceinline__ void dma16(const void* g, unsigned lds_addr) {
    asm volatile("s_mov_b32 m0, %1\n\ts_nop 0\n\tglobal_load_lds_dwordx4 %0, off" :: "v"(g), "s"(lds_addr) : "memory", "m0");
}

template <int MIX>
__device__ __forceinline__ void attn_unit(const AttnP& P, int b, int h, int qb, ldsp lds, int wid, int lane) {
    constexpr int NC = (MIX == 2) ? 2 : 1;
    constexpr int ND = (MIX == 0) ? 6 : (MIX == 1) ? 4 : 2;
    constexpr int NKP = (MIX == 0) ? 12 : 8;
    const int r32 = lane & 31, hi = lane >> 5;
    const int q0 = qb * 256;
    const size_t rowb = (size_t)b * S;
    int kt0 = 0, nt = S / 64;
    if (MIX == 1) { const int klo = max(0, q0 - 128), khi = min(S, q0 + 256 + 128); kt0 = klo / 64; nt = (khi - klo) / 64; }
    bf16x8 qf[NC][ND];
    {
        const unsigned short* qrow = P.Q + (rowb + q0 + wid * 32 + r32) * P.qp + P.qc + h * P.qhs + hi * 8;
#pragma unroll
        for (int c = 0; c < NC; ++c)
#pragma unroll
            for (int d0 = 0; d0 < ND; ++d0) qf[c][d0] = *(const bf16x8*)(qrow + c * (ND * 16) + d0 * 16);
    }
    const unsigned short* Kb = P.K + rowb * P.kp + P.kc + (h / P.kgrp) * P.khs;
    const unsigned short* K2b = (MIX == 0) ? P.K2 + rowb * P.k2p : nullptr;
    const unsigned short* Vb = P.V + rowb * P.vp + P.vc + (h / P.vgrp) * P.vhs;
    __attribute__((address_space(3))) float* wsf = (__attribute__((address_space(3))) float*)(lds + WS_OFF) + wid * 256;
    constexpr bool NEGM = (MIX != 2);
    float mhat[NC], lsum[NC]; f32x16 o[NC][2], negm[NEGM ? NC : 1];
#pragma unroll
    for (int c = 0; c < NC; ++c) {
        mhat[c] = 0.f; lsum[c] = 0.f;
        if (MIX == 1) { mhat[c] = P.sink[h] * LOG2E; lsum[c] = (hi == 0) ? 1.f : 0.f; }
#pragma unroll
        for (int r = 0; r < 16; ++r) { o[c][0][r] = 0.f; o[c][1][r] = 0.f; if (NEGM) negm[c][r] = -mhat[c]; }
    }
    const unsigned short* psrc[3]; unsigned pstep[3], pdst[3], pslot[3];
#pragma unroll
    for (int pp = 0; pp < 3; ++pp) {
        const int p = wid + pp * 8;
        psrc[pp] = nullptr; pstep[pp] = 0; pdst[pp] = 0; pslot[pp] = 0;
        if (p < NKP + 8) {
            if (p < NKP) {
                if (MIX == 0 && p >= 8) { psrc[pp] = K2b + ((size_t)kt0 * 64 + lane) * P.k2p + (p - 8) * 8; pstep[pp] = 64u * (unsigned)P.k2p * 2u; }
                else { psrc[pp] = Kb + ((size_t)kt0 * 64 + lane) * P.kp + p * 8; pstep[pp] = 64u * (unsigned)P.kp * 2u; }
                pdst[pp] = K_OFF + p * 1024; pslot[pp] = KSLOT;
            } else {
                const int pv = p - NKP, d0 = pv >> 2, ks = pv & 3;
                psrc[pp] = Vb + ((size_t)kt0 * 64 + 16 * ks + (lane >> 2)) * P.vp + d0 * 32 + (lane & 3) * 8; pstep[pp] = 64u * (unsigned)P.vp * 2u;
                pdst[pp] = V_OFF + pv * 1024; pslot[pp] = VSLOT;
            }
        }
    }
    auto issue = [&](int j, int slot) {
#pragma unroll
        for (int pp = 0; pp < 3; ++pp) {
            if (pp < 2 || wid + 16 < NKP + 8)
                dma16((const char*)psrc[pp] + (size_t)j * pstep[pp], (unsigned)__builtin_amdgcn_readfirstlane((int)(unsigned)(size_t)(lds + pdst[pp] + slot * pslot[pp])));
        }
    };
    auto compute = [&](int j, int slot, bool first) {
        if (MIX == 1) { const int kb = (kt0 + j) * 64, qw = q0 + wid * 32; if (kb > qw + 31 + 128 || kb + 63 < qw - 128) return; }
        int ln = lane; asm volatile("" : "+v"(ln));
        const int voff = (4 * (ln >> 5) + ((ln & 15) >> 2)) * 64 + ((ln >> 4) & 1) * 32 + (ln & 3) * 8;
        const ldsp Ks = lds + K_OFF + slot * KSLOT, Vs = lds + V_OFF + slot * VSLOT;
        bf16x8 pw[NC][4];
        bf16x8 kf[NC][ND][2];
#pragma unroll
        for (int c = 0; c < NC; ++c)
#pragma unroll
            for (int d0 = 0; d0 < ND; ++d0) {
                kf[c][d0][0] = *(const __attribute__((address_space(3))) bf16x8*)(Ks + (c * 2 * ND + 2 * d0 + (ln >> 5)) * 1024 + (ln & 31) * 16);
                kf[c][d0][1] = *(const __attribute__((address_space(3))) bf16x8*)(Ks + (c * 2 * ND + 2 * d0 + (ln >> 5)) * 1024 + 512 + (ln & 31) * 16);
            }
        __builtin_amdgcn_sched_barrier(0);
        s16x4 vlo[2][4], vhi[2][4];
#pragma unroll
        for (int c = 0; c < NC; ++c) {
            f32x16 p0, p1;
            if (NEGM) { p0 = negm[c]; p1 = negm[c]; }
            else { const float nm_ = -mhat[c];
#pragma unroll
                for (int r = 0; r < 16; ++r) { p0[r] = nm_; p1[r] = nm_; } }
            __builtin_amdgcn_s_setprio(1);
#pragma unroll
            for (int d0 = 0; d0 < ND; ++d0) {
                p0 = __builtin_amdgcn_mfma_f32_32x32x16_bf16(kf[c][d0][0], qf[c][d0], p0, 0, 0, 0);
                p1 = __builtin_amdgcn_mfma_f32_32x32x16_bf16(kf[c][d0][1], qf[c][d0], p1, 0, 0, 0);
            }
            __builtin_amdgcn_s_setprio(0);
            if (MIX != 2 && c == NC - 1) {
#pragma unroll
                for (int d0v = 0; d0v < 2; ++d0v)
#pragma unroll
                    for (int ks = 0; ks < 4; ++ks) { vlo[d0v][ks] = vtr(Vs + d0v * 4096 + ks * 1024 + voff); vhi[d0v][ks] = vtr(Vs + d0v * 4096 + ks * 1024 + 512 + voff); }
                __builtin_amdgcn_sched_barrier(0);
            }
            if (MIX == 1 && (((kt0 + j) * 64 < q0 + wid * 32 + 31 - 128) || ((kt0 + j) * 64 + 63 > q0 + wid * 32 + 128))) {
                const int q = q0 + wid * 32 + r32, kb = (kt0 + j) * 64;
#pragma unroll
                for (int r = 0; r < 16; ++r) { const int k0 = kb + crow(r, hi), k1 = k0 + 32;
                    if (k0 < q - 128 || k0 > q + 128) p0[r] = -INFINITY;
                    if (k1 < q - 128 || k1 > q + 128) p1[r] = -INFINITY; }
            }
            asm volatile("s_nop 15\n\ts_nop 7" : "+v"(p0), "+v"(p1));
            float rm;
            {
                float ma = max3f(p0[0], p0[1], p1[0]), mb = max3f(p0[2], p0[3], p1[1]), mc = max3f(p0[4], p0[5], p1[2]), md = max3f(p0[6], p0[7], p1[3]);
                ma = max3f(ma, p1[4], p1[5]); mb = max3f(mb, p1[6], p1[7]);
#pragma unroll
                for (int r = 8; r < 16; r += 4) { ma = max3f(ma, p0[r], p0[r + 1]); mb = max3f(mb, p0[r + 2], p0[r + 3]); mc = max3f(mc, p1[r], p1[r + 1]); md = max3f(md, p1[r + 2], p1[r + 3]); }
                rm = max2f(max2f(ma, mb), max2f(mc, md));
                unsigned ru = __float_as_uint(rm); asm volatile("s_nop 1" : "+v"(ru));
                const auto rr2 = __builtin_amdgcn_permlane32_swap(ru, ru, false, false);
                rm = max2f(__uint_as_float(rr2[0]), __uint_as_float(rr2[1]));
            }
            const bool trig = first || __any(rm > THR);
            if (trig) {
                const float dl = first ? rm : fmaxf(rm, 0.f);
                mhat[c] += dl;
#pragma unroll
                for (int r = 0; r < 16; ++r) { p0[r] -= dl; p1[r] -= dl; if (NEGM) negm[c][r] = -mhat[c]; }
                if (!first) {
                    const float f = __builtin_amdgcn_exp2f(-dl);
                    lsum[c] *= f;
                    if (hi == 0) wsf[r32] = f;
                    asm volatile("s_waitcnt lgkmcnt(0)" ::: "memory");
#pragma unroll
                    for (int r = 0; r < 16; ++r) { const float fr_ = wsf[crow(r, hi)]; o[c][0][r] *= fr_; o[c][1][r] *= fr_; }
                    asm volatile("s_waitcnt lgkmcnt(0)" ::: "memory");
                }
            }
            float sa4[4] = {0.f, 0.f, 0.f, 0.f};
#pragma unroll
            for (int r = 0; r < 16; ++r) { p0[r] = __builtin_amdgcn_exp2f(p0[r]); p1[r] = __builtin_amdgcn_exp2f(p1[r]); sa4[r & 3] += p0[r] + p1[r]; }
            lsum[c] += (sa4[0] + sa4[1]) + (sa4[2] + sa4[3]);
            {
                unsigned w[16];
#pragma unroll
                for (int i = 0; i < 8; ++i) { w[i] = pg8::cvt_pk_bf16(p0[2 * i], p0[2 * i + 1]); w[8 + i] = pg8::cvt_pk_bf16(p1[2 * i], p1[2 * i + 1]); }
#pragma unroll
                for (int ks = 0; ks < 4; ++ks) { pg8::u32x4 t = {w[4 * ks], w[4 * ks + 1], w[4 * ks + 2], w[4 * ks + 3]}; pw[c][ks] = __builtin_bit_cast(bf16x8, t); }
            }
        }
#pragma unroll
        for (int d0v = 0; d0v < 2; ++d0v) {
            if (MIX == 2) {
#pragma unroll
                for (int ks = 0; ks < 4; ++ks) { vlo[d0v][ks] = vtr(Vs + d0v * 4096 + ks * 1024 + voff); vhi[d0v][ks] = vtr(Vs + d0v * 4096 + ks * 1024 + 512 + voff); }
                __builtin_amdgcn_sched_barrier(0);
            }
            __builtin_amdgcn_s_setprio(1);
#pragma unroll
            for (int ks = 0; ks < 4; ++ks) {
                const bf16x8 vf = {vlo[d0v][ks][0], vlo[d0v][ks][1], vlo[d0v][ks][2], vlo[d0v][ks][3], vhi[d0v][ks][0], vhi[d0v][ks][1], vhi[d0v][ks][2], vhi[d0v][ks][3]};
#pragma unroll
                for (int c = 0; c < NC; ++c) o[c][d0v] = __builtin_amdgcn_mfma_f32_32x32x16_bf16(pw[c][ks], vf, o[c][d0v], 0, 0, 0);
            }
            __builtin_amdgcn_s_setprio(0);
        }
    };
    issue(0, 0);
    ATT_WAIT_BAR();
    if (nt > 1) issue(1, 1);
    compute(0, 0, MIX != 1);
    ATT_WAIT_BAR();
#pragma unroll 1
    for (int j = 1; j < nt; ++j) {
        if (j + 1 < nt) issue(j + 1, (j + 1) & 1);
        compute(j, j & 1, false);
        ATT_WAIT_BAR();
    }
    float rl[NC][16];
#pragma unroll
    for (int c = 0; c < NC; ++c) {
        const float lt = lsum[c] + __shfl_xor(lsum[c], 32);
        if (hi == 0) wsf[32 + c * 32 + r32] = lt;
    }
    asm volatile("s_waitcnt lgkmcnt(0)" ::: "memory");
#pragma unroll
    for (int c = 0; c < NC; ++c)
#pragma unroll
        for (int r = 0; r < 16; ++r) rl[c][r] = __builtin_amdgcn_rcpf(wsf[32 + c * 32 + crow(r, hi)]);
    asm volatile("s_waitcnt lgkmcnt(0)" ::: "memory");
    __attribute__((address_space(3))) unsigned short* stg = (__attribute__((address_space(3))) unsigned short*)(lds + OST_OFF) + wid * 2048;
    if (MIX != 2) {
#pragma unroll
        for (int r = 0; r < 16; ++r)
#pragma unroll
            for (int d0v = 0; d0v < 2; ++d0v) stg[crow(r, hi) * 64 + d0v * 32 + r32] = (unsigned short)(pg8::cvt_pk_bf16(o[0][d0v][r] * rl[0][r], 0.f) & 0xffffu);
    } else {
        const float g0 = P.subln[r32] * P.omli, g1 = P.subln[32 + r32] * P.omli;
#pragma unroll
        for (int r = 0; r < 16; ++r) {
            const float v0 = o[0][0][r] * rl[0][r] - P.lam * (o[NC - 1][0][r] * rl[NC - 1][r]);
            const float v1 = o[0][1][r] * rl[0][r] - P.lam * (o[NC - 1][1][r] * rl[NC - 1][r]);
            float ss = v0 * v0 + v1 * v1;
            ss += __shfl_xor(ss, 1); ss += __shfl_xor(ss, 2); ss += __shfl_xor(ss, 4); ss += __shfl_xor(ss, 8); ss += __shfl_xor(ss, 16);
            const float rr = rsqrtf(ss * (1.0f / 64.0f) + EPS);
            stg[crow(r, hi) * 64 + r32] = (unsigned short)(pg8::cvt_pk_bf16(v0 * rr * g0, 0.f) & 0xffffu);
            stg[crow(r, hi) * 64 + 32 + r32] = (unsigned short)(pg8::cvt_pk_bf16(v1 * rr * g1, 0.f) & 0xffffu);
        }
    }
    asm volatile("s_waitcnt lgkmcnt(0)" ::: "memory");
    unsigned short* Ow = P.O + (rowb + q0 + wid * 32) * P.op + P.oc + h * P.ohs;
#pragma unroll
    for (int i = 0; i < 4; ++i) { const int row = i * 8 + (lane >> 3), ch = lane & 7;
        const pg8::u32x4 v = *(const __attribute__((address_space(3))) pg8::u32x4*)(stg + row * 64 + ch * 8);
        asm volatile("global_store_dwordx4 %0, %1, off sc1\n\ts_nop 1" :: "v"(Ow + (size_t)row * P.op + ch * 8), "v"(v) : "memory"); }
    asm volatile("s_waitcnt vmcnt(0) lgkmcnt(0)" ::: "memory");
    if (lane == 0) __hip_atomic_fetch_add(P.done + (b * 8 + qb) * 16, 1u, __ATOMIC_RELAXED, __HIP_MEMORY_SCOPE_AGENT);
}
}
#define GAS __attribute__((address_space(1)))
#define LAS __attribute__((address_space(3)))
typedef unsigned short bf16;
typedef unsigned v4u __attribute__((ext_vector_type(4)));
typedef unsigned v2u __attribute__((ext_vector_type(2)));
typedef float f32x4 __attribute__((ext_vector_type(4)));
constexpr int NWAVES = 8;
constexpr int LDS_BYTES = 147456;
constexpr int LDS_MISC = 131072;
#define LDS_WAIT() asm volatile("s_waitcnt lgkmcnt(0)" ::: "memory")
#define VM_WAIT() asm volatile("s_waitcnt vmcnt(0)" ::: "memory")
__device__ __forceinline__ unsigned pk2(float lo, float hi) { return pg8::cvt_pk_bf16(lo, hi); }
__device__ __forceinline__ bf16 f2bf(float v) { return (bf16)(pg8::cvt_pk_bf16(v, 0.f) & 0xffffu); }
__device__ __forceinline__ float bf2f(unsigned short b) { return __uint_as_float((unsigned)b << 16); }
constexpr float LOG2E = 1.4426950408889634f;

struct Args {
    const float* in[23];
    float* out;
    unsigned char* ws;
    int phase, layer, rep, pad1;
};
constexpr size_t MiB = 1u << 20, KiB = 1u << 10;
constexpr size_t WS_CTL = 0;
constexpr size_t CTL_BYTES = 64 * KiB;
constexpr size_t CTL_CNT = 0;
constexpr size_t CTL_ATTQ = 4 * KiB;
constexpr size_t CTL_MOEQ = 8 * KiB;
constexpr size_t CTL_SEAM = 16 * KiB;
constexpr size_t CTL_BAR = 48 * KiB;
constexpr size_t WS_RA = 1 * MiB;
constexpr size_t WS_RF = WS_RA + 64 * KiB;
constexpr size_t WS_KROPE = WS_RF + 64 * KiB;
constexpr size_t WS_CS32 = WS_KROPE + 1 * MiB;
constexpr size_t WS_CS64 = WS_CS32 + 256 * KiB;
constexpr size_t WS_SLOTW = 3 * MiB;
constexpr size_t WS_SSQP = 3 * MiB + 256 * KiB;
constexpr size_t WS_LIST = 5 * MiB;
constexpr int LCAP = 16384;
constexpr size_t WS_WSMALL = 7 * MiB;
constexpr size_t WSM_LAYER = 7 * MiB, WSM_IN = 0, WSM_UQ = 4 * MiB, WSM_UKV = 4 * MiB + 640 * KiB, WSM_OUT = 5 * MiB;
constexpr size_t WS_WGU = 21 * MiB;
constexpr size_t WS_WD = 53 * MiB;
constexpr size_t WS_XB = 69 * MiB;
constexpr size_t WS_XA = 101 * MiB;
constexpr size_t WS_U = 165 * MiB;
constexpr size_t WS_QM = 229 * MiB;
constexpr size_t WS_KVM = 247 * MiB;
constexpr size_t WS_SPLIT = 271 * MiB;
constexpr size_t SPL_LAYER = 512 * KiB, SPL_KR = 0, SPL_RT = 128 * KiB;
constexpr size_t WS_END = 272 * MiB;

__device__ __forceinline__ int lane_id() { int ln; asm volatile("v_mbcnt_lo_u32_b32 %0, -1, 0\n\tv_mbcnt_hi_u32_b32 %0, -1, %0" : "=v"(ln)); return ln; }
typedef const __attribute__((address_space(4))) Args* AP;
__device__ __forceinline__ AP launder(AP p) { asm volatile("" : "+s"(p)); return p; }
struct Frame {
    LAS unsigned char* lds;
    int wave, vcu, G;
    int lane;
    __device__ __forceinline__ int lane_() const { return lane; }
};
__device__ __forceinline__ unsigned* seam_ctr(unsigned char* ws, int l, int seam, int blk) { return (unsigned*)(ws + WS_CTL + CTL_SEAM) + ((size_t)((l * 4 + seam) * 64 + blk)) * 16; }
#define F_LANE (lane_id())
#define F_TID (F.wave * 64 + lane_id())

__device__ __forceinline__ void seam_publish(const Frame& F, unsigned* ctr) {
    asm volatile("s_waitcnt vmcnt(0)" ::: "memory");
    __syncthreads();
    if (F.wave == 0 && F_LANE == 0) {
        __builtin_amdgcn_fence(__ATOMIC_RELEASE, "agent");
        asm volatile("s_waitcnt vmcnt(0)" ::: "memory");
        __hip_atomic_fetch_add(ctr, 1u, __ATOMIC_RELAXED, __HIP_MEMORY_SCOPE_AGENT);
    }
}
__device__ __forceinline__ void seam_wait(const Frame& F, unsigned* ctr, unsigned need) {
    if (F.wave == 0 && F_LANE == 0) {
        unsigned sp = 0;
        while (__hip_atomic_load(ctr, __ATOMIC_RELAXED, __HIP_MEMORY_SCOPE_AGENT) < need) { __builtin_amdgcn_s_sleep(1); if (++sp > (1u << 24)) break; }
        __builtin_amdgcn_fence(__ATOMIC_ACQUIRE, "agent");
        asm volatile("s_waitcnt vmcnt(0)" ::: "memory");
    }
    __syncthreads();
}
__device__ __forceinline__ float2 cossin_f(float ang) {
    const double x = (double)ang;
    const double k = rint(x * 0.15915494309189535);
    double r = fma(-k, 6.283185307179586, x);
    float sg = 1.f;
    if (r > 1.5707963267948966) { r = 3.141592653589793 - r; sg = -1.f; } else if (r < -1.5707963267948966) { r = -3.141592653589793 - r; sg = -1.f; }
    const float t = (float)r, t2 = t * t;
    float sp = 1.0f / 6227020800.0f;
    sp = fmaf(sp, t2, -1.0f / 39916800.0f); sp = fmaf(sp, t2, 1.0f / 362880.0f); sp = fmaf(sp, t2, -1.0f / 5040.0f); sp = fmaf(sp, t2, 1.0f / 120.0f); sp = fmaf(sp, t2, -1.0f / 6.0f);
    const float sn = fmaf(sp * t2, t, t);
    float cp = 1.0f / 479001600.0f;
    cp = fmaf(cp, t2, -1.0f / 3628800.0f); cp = fmaf(cp, t2, 1.0f / 40320.0f); cp = fmaf(cp, t2, -1.0f / 720.0f); cp = fmaf(cp, t2, 1.0f / 24.0f); cp = fmaf(cp, t2, -0.5f);
    const float cn = fmaf(cp, t2, 1.0f);
    return make_float2(sg * cn, sn);
}
__device__ __forceinline__ void transpose_item2(const float* srcA, int cA, const float* srcB, int cB, int ldw, const float* gain, bf16* WT, int ldt, int k0, int n0d, LAS float* scr, int lane) {
    (void)scr;
    const int n4 = lane & 7, kg = lane >> 3;
    const float* sp = ((n4 < 4) ? srcA + cA + 4 * n4 : srcB + cB + 4 * (n4 - 4)) + (size_t)(k0 + kg * 8) * ldw;
    f32x4 v[8];
#pragma unroll
    for (int r = 0; r < 8; ++r) v[r] = __builtin_nontemporal_load((const f32x4*)(sp + (size_t)r * ldw));
    if (gain) {
        const f32x4 g0 = *(const f32x4*)(gain + k0 + kg * 8), g1 = *(const f32x4*)(gain + k0 + kg * 8 + 4);
#pragma unroll
        for (int r = 0; r < 4; ++r) { v[r] = v[r] * g0[r]; v[4 + r] = v[4 + r] * g1[r]; }
    }
#pragma unroll
    for (int c = 0; c < 4; ++c) {
        v4u o; o.x = pk2(v[0][c], v[1][c]); o.y = pk2(v[2][c], v[3][c]); o.z = pk2(v[4][c], v[5][c]); o.w = pk2(v[6][c], v[7][c]);
        *(GAS v4u*)(WT + (size_t)(n0d + 4 * n4 + c) * ldt + k0 + kg * 8) = o;
    }
}
__device__ __forceinline__ void ucol_src(int G32, int& cA, int& cB) {
    const int c = G32 * 32;
    if (c < 640) { cA = c; cB = c + 16; }
    else if (c < 1152) {
        const int rel = c - 640, hh = rel / 64, gi = (rel % 64) / 32; const int base = 672 + hh * 64;
        cA = base + 16 * gi; cB = base + 32 + 16 * gi; }
    else { cA = c + 32; cB = c + 48; }
}
constexpr int P0_I_IN = 16 * 64, P0_I_UQ = 6 * 24, P0_I_UKV = 4 * 24, P0_I_OUT = 16 * 32, P0_I_L = P0_I_IN + P0_I_UQ + P0_I_UKV + P0_I_OUT;
__device__ __forceinline__ void p0_item(const Frame& F, AP a, int l, int r, int lane_) {
    LAS float* scr = nullptr;
    unsigned char* wl = a->ws + WS_WSMALL + (size_t)l * WSM_LAYER;
    if (r < P0_I_IN) { const int kb = r / 64, nb = r % 64; int cA, cB; ucol_src(nb, cA, cB); const float* W = a->in[2] + (size_t)l * D * INW;
        transpose_item2(W, cA, W, cB, INW, a->in[1] + l * D, (bf16*)(wl + WSM_IN), 1024, kb * 64, nb * 32, scr, lane_); return; }
    r -= P0_I_IN;
    if (r < P0_I_UQ) { const int kb = r / 24, nb = r % 24; bf16* WT = (bf16*)(wl + WSM_UQ);
        if (nb < 18) { const float* W = a->in[5] + (size_t)l * 384 * 576; transpose_item2(W, nb * 32, W, nb * 32 + 16, 576, a->in[3] + l * 384, WT, 384, kb * 64, nb * 32, scr, lane_); }
        else { for (int n = 0; n < 32; ++n) WT[(size_t)(nb * 32 + n) * 384 + kb * 64 + lane_] = 0; }
        return; }
    r -= P0_I_UQ;
    if (r < P0_I_UKV) { const int kb = r / 24, nb = r % 24; const float* W = a->in[6] + (size_t)l * 256 * 768;
        transpose_item2(W, nb * 32, W, nb * 32 + 16, 768, a->in[4] + l * 256, (bf16*)(wl + WSM_UKV), 256, kb * 64, nb * 32, scr, lane_); return; }
    r -= P0_I_UKV;
    { const int kb = r / 32, nb = r % 32; const float* W = a->in[13] + (size_t)l * D * D;
        transpose_item2(W, nb * 32, W, nb * 32 + 16, D, nullptr, (bf16*)(wl + WSM_OUT), 1024, kb * 64, nb * 32, scr, lane_); }
}
constexpr int P0_FIRST = P0_I_L, P0_REST = P0_I_L, P0_REST_CHUNKS = (P0_REST + 63) / 64;
__device__ __forceinline__ void p0_rest_chunk(const Frame& F, AP a, int u) {
#pragma unroll 1
    for (int k = 0; k < 8; ++k) {
        const int j = u * 64 + k * 8 + F.wave;
        int ln = lane_id(); asm volatile("" : "+v"(ln));
        if (j < P0_REST) p0_item(F, a, 1, j, ln);
    }
}
__device__ __forceinline__ void p0_small(const Frame& F, AP a) {
    const int gw = F.vcu * NWAVES + F.wave, NGW = F.G * NWAVES;
#pragma unroll 1
    for (int it = gw; it < P0_FIRST; it += NGW) p0_item(F, a, 0, it, F_LANE);
    float2* cs32 = (float2*)(a->ws + WS_CS32); float2* cs64 = (float2*)(a->ws + WS_CS64);
#pragma unroll 1
    for (int i = F.vcu * 512 + F_TID; i < S * 32; i += F.G * 512) {
        { const int s = i / 32, f = i % 32; const float inv = 1.0f / powf(10000.0f, (float)(2 * f) / 64.0f); const float ang = (float)s * inv;
          cs64[i] = cossin_f(ang); }
        if (i < S * 16) { const int s = i / 16, f = i % 16; const float inv = 1.0f / powf(10000.0f, (float)(2 * f) / 32.0f); const float ang = (float)s * inv;
          cs32[i] = cossin_f(ang); }
    }
#pragma unroll 1
    for (int i = F.vcu * 512 + F_TID; i < 2 * 80 * 128; i += F.G * 512) {
        const int l = i / (80 * 128), rem = i % (80 * 128), k8 = rem / 80, n = rem % 80;
        const bool kr = n < 32; const int nn = kr ? n : n - 32;
        const float* gain = (kr ? a->in[1] : a->in[14]) + l * D;
        float v[8];
#pragma unroll
        for (int r = 0; r < 8; ++r) {
            const int k = k8 * 8 + r; float wv = 0.f;
            if (kr) wv = a->in[2][(size_t)l * D * INW + (size_t)k * INW + 640 + nn];
            else if (nn < 32) wv = a->in[17][(size_t)l * D * 32 + k * 32 + nn];
            else if (nn < 36) wv = a->in[15][(size_t)l * D * 4 + k * 4 + (nn - 32)];
            v[r] = wv * gain[k];
        }
        v4u hi, lo;
        hi.x = pk2(v[0], v[1]); hi.y = pk2(v[2], v[3]); hi.z = pk2(v[4], v[5]); hi.w = pk2(v[6], v[7]);
        lo.x = pk2(v[0] - __uint_as_float(hi.x << 16), v[1] - __uint_as_float(hi.x & 0xffff0000u)); lo.y = pk2(v[2] - __uint_as_float(hi.y << 16), v[3] - __uint_as_float(hi.y & 0xffff0000u));
        lo.z = pk2(v[4] - __uint_as_float(hi.z << 16), v[5] - __uint_as_float(hi.z & 0xffff0000u)); lo.w = pk2(v[6] - __uint_as_float(hi.w << 16), v[7] - __uint_as_float(hi.w & 0xffff0000u));
        bf16* dst = (bf16*)(a->ws + WS_SPLIT + (size_t)l * SPL_LAYER + (kr ? SPL_KR : SPL_RT)) + (size_t)nn * 1024 + k8 * 8;
        *(v4u*)dst = hi; *(v4u*)(dst + (kr ? 32 : 48) * 1024) = lo;
    }
}
__device__ __forceinline__ void p0_experts(const Frame& F, AP a, int l) {
    LAS float* scr = (LAS float*)(F.lds + F.wave * 16384);
    const int gw = F.vcu * NWAVES + F.wave, NGW = F.G * NWAVES;
    constexpr int I_GU = 16 * 16, I_D = 4 * 32, I_E = I_GU + I_D;
    const float* Wg = a->in[19] + (size_t)l * NE * D * FF; const float* Wu = a->in[20] + (size_t)l * NE * D * FF; const float* Wdn = a->in[21] + (size_t)l * NE * FF * D;
#pragma unroll 1
    for (int it = gw; it < NE * I_E; it += NGW) {
        const int e = it / I_E; int r = it % I_E;
        if (r < I_GU) { const int kb = r / 16, nb = r % 16;
            transpose_item2(Wg + (size_t)e * D * FF, nb * 16, Wu + (size_t)e * D * FF, nb * 16, FF, a->in[14] + l * D, (bf16*)(a->ws + WS_WGU) + (size_t)e * 512 * 1024, 1024, kb * 64, nb * 32, scr, F_LANE); }
        else { r -= I_GU; const int kb = r / 32, nb = r % 32; const float* W = Wdn + (size_t)e * FF * D;
            transpose_item2(W, nb * 32, W, nb * 32 + 16, D, nullptr, (bf16*)(a->ws + WS_WD) + (size_t)e * 1024 * 256, 256, kb * 64, nb * 32, scr, F_LANE); }
    }
}

constexpr int CONV_CHUNKS = NE * 384 / 64;
#ifndef CONV_MOD
#define CONV_MOD 6
#endif
struct TItem { f32x4 v[8]; f32x4 g0, g1; };
__device__ __forceinline__ void ti_load(TItem& t, const float* srcA, int cA, const float* srcB, int cB, int ldw, const float* gain, int k0, int lane) {
    const int n4 = lane & 7, kg = lane >> 3;
    const float* sp = ((n4 < 4) ? srcA + cA + 4 * n4 : srcB + cB + 4 * (n4 - 4)) + (size_t)(k0 + kg * 8) * ldw;
#pragma unroll
    for (int r = 0; r < 8; ++r) t.v[r] = __builtin_nontemporal_load((const f32x4*)(sp + (size_t)r * ldw));
    if (gain) { t.g0 = *(const f32x4*)(gain + k0 + kg * 8); t.g1 = *(const f32x4*)(gain + k0 + kg * 8 + 4); }
}
__device__ __forceinline__ void ti_store(TItem& t, bool gain, bf16* WT, int ldt, int k0, int n0d, int lane) {
    const int n4 = lane & 7, kg = lane >> 3;
    if (gain) {
#pragma unroll
        for (int r = 0; r < 4; ++r) { t.v[r] = t.v[r] * t.g0[r]; t.v[4 + r] = t.v[4 + r] * t.g1[r]; }
    }
#pragma unroll
    for (int c = 0; c < 4; ++c) {
        v4u o; o.x = pk2(t.v[0][c], t.v[1][c]); o.y = pk2(t.v[2][c], t.v[3][c]); o.z = pk2(t.v[4][c], t.v[5][c]); o.w = pk2(t.v[6][c], t.v[7][c]);
        *(GAS v4u*)(WT + (size_t)(n0d + 4 * n4 + c) * ldt + k0 + kg * 8) = o;
    }
}
__device__ __forceinline__ void conv_chunk(const Frame& F, AP a, int l, int u) {
    const int e = u / 6, c6 = u % 6, lane = F_LANE;
    const bool gu = c6 < 4;
    const float* sA; const float* sB; int ldw, ldt; const float* gain; bf16* WT;
    if (gu) { sA = a->in[19] + ((size_t)l * NE + e) * D * FF; sB = a->in[20] + ((size_t)l * NE + e) * D * FF; ldw = FF; ldt = 1024; gain = a->in[14] + l * D; WT = (bf16*)(a->ws + WS_WGU) + (size_t)e * 512 * 1024; }
    else { sA = sB = a->in[21] + ((size_t)l * NE + e) * FF * D; ldw = D; ldt = 256; gain = nullptr; WT = (bf16*)(a->ws + WS_WD) + (size_t)e * 1024 * 256; }
    const int rbase = (gu ? c6 * 64 : (c6 - 4) * 64) + F.wave;
#define CV_LOAD(T, k) do { const int r = rbase + 8 * (k); const int kb = gu ? r / 16 : r / 32, nb = gu ? r % 16 : r % 32; \
        ti_load(T, sA, gu ? nb * 16 : nb * 32, sB, gu ? nb * 16 : nb * 32 + 16, ldw, gain, kb * 64, lane); } while (0)
#define CV_STORE(T, k) do { const int r = rbase + 8 * (k); const int kb = gu ? r / 16 : r / 32, nb = gu ? r % 16 : r % 32; \
        ti_store(T, gu, WT, ldt, kb * 64, nb * 32, lane); } while (0)
    TItem t0, t1;
    CV_LOAD(t0, 0); CV_LOAD(t1, 1);
    __builtin_amdgcn_sched_barrier(0);
#pragma unroll 1
    for (int k = 0; k < 6; k += 2) {
        CV_STORE(t0, k); __builtin_amdgcn_sched_barrier(0); CV_LOAD(t0, k + 2); __builtin_amdgcn_sched_barrier(0);
        CV_STORE(t1, k + 1); __builtin_amdgcn_sched_barrier(0); CV_LOAD(t1, k + 3); __builtin_amdgcn_sched_barrier(0);
    }
    CV_STORE(t0, 6); CV_STORE(t1, 7);
#undef CV_LOAD
#undef CV_STORE
}

__device__ __forceinline__ float reduce32(const float (&a)[32], int lane) {
    float b16[16], b8[8], b4[4], b2[2];
#pragma unroll
    for (int o = 0; o < 16; ++o) { const float send = (lane & 32) ? a[o] : a[o + 16], keep = (lane & 32) ? a[o + 16] : a[o]; b16[o] = keep + __shfl_xor(send, 32); }
#pragma unroll
    for (int o = 0; o < 8; ++o) { const float send = (lane & 16) ? b16[o] : b16[o + 8], keep = (lane & 16) ? b16[o + 8] : b16[o]; b8[o] = keep + __shfl_xor(send, 16); }
#pragma unroll
    for (int o = 0; o < 4; ++o) { const float send = (lane & 8) ? b8[o] : b8[o + 4], keep = (lane & 8) ? b8[o + 4] : b8[o]; b4[o] = keep + __shfl_xor(send, 8); }
#pragma unroll
    for (int o = 0; o < 2; ++o) { const float send = (lane & 4) ? b4[o] : b4[o + 2], keep = (lane & 4) ? b4[o + 2] : b4[o]; b2[o] = keep + __shfl_xor(send, 4); }
    const float send = (lane & 2) ? b2[0] : b2[1], keep = (lane & 2) ? b2[1] : b2[0];
    float v = keep + __shfl_xor(send, 2);
    v += __shfl_xor(v, 1);
    return v;
}

__device__ __forceinline__ float wave_sum4(float s0, float s1, float s2, float s3, int lane) {
    const bool h5 = lane & 32, h4 = lane & 16;
    const float b0 = (h5 ? s2 : s0) + __shfl_xor(h5 ? s0 : s2, 32), b1 = (h5 ? s3 : s1) + __shfl_xor(h5 ? s1 : s3, 32);
    float c = (h4 ? b1 : b0) + __shfl_xor(h4 ? b0 : b1, 16);
    c += __shfl_xor(c, 8); c += __shfl_xor(c, 4); c += __shfl_xor(c, 2); c += __shfl_xor(c, 1);
    return c;
}
template <int MODE>
__device__ __forceinline__ void norm_pass(const Frame& F, AP a, int l) {
    const int gw = F.vcu * NWAVES + F.wave, NGW = F.G * NWAVES, lane = F_LANE;
    const float* g = a->in[22];
    const bf16* XA = (const bf16*)(a->ws + WS_XA);
    const bf16* ys = (const bf16*)(a->ws + WS_U);
#pragma unroll 1
    for (int t0 = gw * 4; t0 < T; t0 += NGW * 4) {
        float xv[4][16]; v2u yy[4][8];
#pragma unroll
        for (int tk = 0; tk < 4; ++tk) {
            const int t = t0 + tk;
#pragma unroll
            for (int j = 0; j < 4; ++j) {
                const v2u v = __builtin_nontemporal_load((const v2u*)(XA + (size_t)t * D + j * 256 + lane * 4));
                xv[tk][j * 4 + 0] = __uint_as_float(v.x << 16); xv[tk][j * 4 + 1] = __uint_as_float(v.x & 0xffff0000u); xv[tk][j * 4 + 2] = __uint_as_float(v.y << 16); xv[tk][j * 4 + 3] = __uint_as_float(v.y & 0xffff0000u);
                yy[tk][j] = __builtin_nontemporal_load((const v2u*)(ys + (size_t)(2 * t) * D + j * 256 + lane * 4)); yy[tk][4 + j] = __builtin_nontemporal_load((const v2u*)(ys + (size_t)(2 * t + 1) * D + j * 256 + lane * 4));
            }
        }
        float ss4[4];
#pragma unroll
        for (int tk = 0; tk < 4; ++tk) {
            const int t = t0 + tk;
            float ss = 0.f;
#pragma unroll
            for (int j = 0; j < 4; ++j) {
                const v2u y0 = yy[tk][j], y1 = yy[tk][4 + j];
                xv[tk][j * 4 + 0] += __uint_as_float(y0.x << 16) + __uint_as_float(y1.x << 16); xv[tk][j * 4 + 1] += __uint_as_float(y0.x & 0xffff0000u) + __uint_as_float(y1.x & 0xffff0000u);
                xv[tk][j * 4 + 2] += __uint_as_float(y0.y << 16) + __uint_as_float(y1.y << 16); xv[tk][j * 4 + 3] += __uint_as_float(y0.y & 0xffff0000u) + __uint_as_float(y1.y & 0xffff0000u);
#pragma unroll
                for (int q = 0; q < 4; ++q) ss += xv[tk][j * 4 + q] * xv[tk][j * 4 + q];
            }
            ss4[tk] = ss;
        }
        const float tot4 = wave_sum4(ss4[0], ss4[1], ss4[2], ss4[3], lane);
#pragma unroll
        for (int tk = 0; tk < 4; ++tk) {
            const int t = t0 + tk;
            const float r = rsqrtf(__uint_as_float((unsigned)__builtin_amdgcn_readlane((int)__float_as_uint(tot4), 16 * tk)) / (float)D + EPS);
#pragma unroll
            for (int j = 0; j < 4; ++j) { const float4 gg = *(const float4*)(g + j * 256 + lane * 4);
                { const f32x4 ov_ = (f32x4){xv[tk][j * 4 + 0] * r * gg.x, xv[tk][j * 4 + 1] * r * gg.y, xv[tk][j * 4 + 2] * r * gg.z, xv[tk][j * 4 + 3] * r * gg.w}; __builtin_nontemporal_store(ov_, (f32x4*)(a->out + (size_t)t * D + j * 256 + lane * 4)); } }
        }
    }
}

constexpr int LP_RS = 2064;
constexpr int LP_LO = 32 * LP_RS;
constexpr int LDS_MISC2 = 135168;
#ifndef LP_D16
#define LP_D16 1
#endif
#ifndef LP_SPLIT
#define LP_SPLIT(K) 0
#endif
#ifndef LP_PREF
#define LP_PREF(K) ((K) != 1)
#endif
#define LP_BAR() asm volatile("s_waitcnt lgkmcnt(0)\n\ts_barrier" ::: "memory")
template <int KIND>
__device__ __forceinline__ void light_pass(const Frame& F, AP a, int l, int rrp = 0) {
    constexpr int NT = (KIND == 3) ? 3 : 2;
    const int lane = F_LANE, w = F.wave, tid = F_TID;
    LAS float* part = (LAS float*)F.lds;
    LAS int* hist = (LAS int*)(F.lds + LDS_MISC2);
    LAS int* tokinfo = hist + 64;
    LAS float* rls = (LAS float*)(F.lds + LDS_MISC2 + 2048);
    const pg8::bf16_t* wsp = (const pg8::bf16_t*)(a->ws + WS_SPLIT + (size_t)l * SPL_LAYER + (KIND == 3 ? SPL_RT : SPL_KR));
    const float* brg = a->in[16] + l * 4; const float* bre = a->in[18] + l * 32;
    bf16* XA = (bf16*)(a->ws + WS_XA);
    float* rout = (float*)(a->ws + (KIND == 3 ? WS_RF : WS_RA));
    bf16* xb = (bf16*)(a->ws + WS_XB); bf16* krope = (bf16*)(a->ws + WS_KROPE);
    const bf16* ys = (const bf16*)(a->ws + WS_U);
    const float2* cs32 = (const float2*)(a->ws + WS_CS32);
    float* slot_w = (float*)(a->ws + WS_SLOTW); int* list = (int*)(a->ws + WS_LIST);
    int* cnt = (int*)(a->ws + WS_CTL + CTL_CNT) + (l + 2 * rrp) * 32;
    const int tbase = F.vcu * 64;
    if (KIND == 3) seam_wait(F, seam_ctr(a->ws, l, 0, F.vcu / 4), 4u);
    if (KIND == 3) { if (tid < 64) hist[tid] = 0; }
    const int fr = lane & 15, fk = lane >> 4;
    f32x4 xq[KIND == 0 ? 4 : 1][4]; v2u xr2[KIND == 0 ? 1 : 4][4]; v2u yq[KIND == 1 ? 4 : 1][4][2];
    auto loadx = [&](int half) {
#pragma unroll
        for (int tk = 0; tk < 4; ++tk) {
            const int t = tbase + half * 32 + 4 * w + tk;
#pragma unroll
            for (int j = 0; j < 4; ++j) {
                if (KIND == 0) xq[KIND == 0 ? tk : 0][j] = __builtin_nontemporal_load((const f32x4*)(a->in[0] + (size_t)t * D + j * 256 + lane * 4));
                else xr2[KIND == 0 ? 0 : tk][j] = *(const v2u*)(XA + (size_t)t * D + j * 256 + lane * 4);
                if (KIND == 1) { yq[KIND == 1 ? tk : 0][j][0] = __builtin_nontemporal_load((const v2u*)(ys + (size_t)(2 * t) * D + j * 256 + lane * 4)); yq[KIND == 1 ? tk : 0][j][1] = __builtin_nontemporal_load((const v2u*)(ys + (size_t)(2 * t + 1) * D + j * 256 + lane * 4)); }
            }
        }
    };
    float brgv[4] = {0.f, 0.f, 0.f, 0.f}, brev = 0.f, brs0 = 0.f, brs1 = 0.f, brs2 = 0.f; float2 csq[2][4];
    if (KIND == 3) {
#pragma unroll
        for (int o = 0; o < 4; ++o) brgv[o] = brg[o];
        brev = bre[lane & 31];
        brs0 = bre[lane & 15]; brs1 = bre[16 + (lane & 15)]; brs2 = brg[lane & 3];
    } else if (LP_PREF(KIND)) {
#pragma unroll
        for (int hh = 0; hh < 2; ++hh)
#pragma unroll
            for (int tk = 0; tk < 4; ++tk) {
                if (KIND == 0) { const float inv = 1.0f / powf(10000.0f, (float)(2 * (lane & 15)) / 32.0f); csq[hh][tk] = cossin_f((float)((tbase + hh * 32 + 4 * w + tk) % S) * inv); }
                else csq[hh][tk] = cs32[((tbase + hh * 32 + 4 * w + tk) % S) * 16 + (lane & 15)];
            }
    }
    constexpr bool PREF = LP_PREF(KIND);
    if (PREF) loadx(0);
    pg8::bf16x8 bH[4][NT], bL[4][NT];
    if (KIND == 0) {
        const float* W = a->in[2] + (size_t)l * D * INW + 640; const float* gn = a->in[1] + l * D;
#pragma unroll
        for (int u = 0; u < 4; ++u) {
            const int k0 = w * 128 + u * 32 + fk * 8;
            const f32x4 g0 = *(const f32x4*)(gn + k0), g1 = *(const f32x4*)(gn + k0 + 4);
#pragma unroll
            for (int nt = 0; nt < NT; ++nt) {
                float v[8];
#pragma unroll
                for (int r = 0; r < 8; ++r) v[r] = W[(size_t)(k0 + r) * INW + nt * 16 + fr] * (r < 4 ? g0[r & 3] : g1[r & 3]);
                v4u hi, lo;
                hi.x = pk2(v[0], v[1]); hi.y = pk2(v[2], v[3]); hi.z = pk2(v[4], v[5]); hi.w = pk2(v[6], v[7]);
                lo.x = pk2(v[0] - __uint_as_float(hi.x << 16), v[1] - __uint_as_float(hi.x & 0xffff0000u)); lo.y = pk2(v[2] - __uint_as_float(hi.y << 16), v[3] - __uint_as_float(hi.y & 0xffff0000u));
                lo.z = pk2(v[4] - __uint_as_float(hi.z << 16), v[5] - __uint_as_float(hi.z & 0xffff0000u)); lo.w = pk2(v[6] - __uint_as_float(hi.w << 16), v[7] - __uint_as_float(hi.w & 0xffff0000u));
                bH[u][nt < NT ? nt : 0] = __builtin_bit_cast(pg8::bf16x8, hi); bL[u][nt < NT ? nt : 0] = __builtin_bit_cast(pg8::bf16x8, lo);
            }
        }
    } else {
        const pg8::bf16_t* bh = wsp + (size_t)fr * 1024 + w * 128 + fk * 8;
#pragma unroll
        for (int u = 0; u < 4; ++u)
#pragma unroll
            for (int nt = 0; nt < NT; ++nt) { bH[u][nt] = *(const pg8::bf16x8*)(bh + (size_t)nt * 16 * 1024 + u * 32); if (LP_SPLIT(KIND)) bL[u][nt] = *(const pg8::bf16x8*)(bh + (size_t)(NT * 16 + nt * 16) * 1024 + u * 32); else bL[u][nt] = bH[u][nt]; }
    }
    LP_BAR();
#pragma unroll
    for (int half = 0; half < 2; ++half) {
        {
            if (!PREF) loadx(half);
            float ssq4[4];
#pragma unroll
            for (int tk = 0; tk < 4; ++tk) {
                const int ti = 4 * w + tk, t = tbase + half * 32 + ti;
                float ss = 0.f;
#pragma unroll
                for (int j = 0; j < 4; ++j) {
                    f32x4 v;
                    if (KIND == 0) v = xq[KIND == 0 ? tk : 0][j];
                    else { const v2u xr_ = xr2[KIND == 0 ? 0 : tk][j]; v = (f32x4){__uint_as_float(xr_.x << 16), __uint_as_float(xr_.x & 0xffff0000u), __uint_as_float(xr_.y << 16), __uint_as_float(xr_.y & 0xffff0000u)}; }
                    if (KIND == 1) {
                        const v2u y0 = yq[KIND == 1 ? tk : 0][j][0], y1 = yq[KIND == 1 ? tk : 0][j][1];
                        v[0] += __uint_as_float(y0.x << 16) + __uint_as_float(y1.x << 16); v[1] += __uint_as_float(y0.x & 0xffff0000u) + __uint_as_float(y1.x & 0xffff0000u);
                        v[2] += __uint_as_float(y0.y << 16) + __uint_as_float(y1.y << 16); v[3] += __uint_as_float(y0.y & 0xffff0000u) + __uint_as_float(y1.y & 0xffff0000u);
                    }
                    ss += (v[0] * v[0] + v[1] * v[1]) + (v[2] * v[2] + v[3] * v[3]);
                    v2u o; o.x = pk2(v[0], v[1]); o.y = pk2(v[2], v[3]);
                    if (KIND == 0) *(v2u*)(XA + (size_t)t * D + j * 256 + lane * 4) = o;
                    if (KIND == 1) *(v2u*)(XA + (size_t)t * D + j * 256 + lane * 4) = o;
                    v2u q; q.x = pk2(v[0] - __uint_as_float(o.x << 16), v[1] - __uint_as_float(o.x & 0xffff0000u));
                    q.y = pk2(v[2] - __uint_as_float(o.y << 16), v[3] - __uint_as_float(o.y & 0xffff0000u));
                    *(LAS v2u*)(F.lds + ti * LP_RS + (j * 256 + lane * 4) * 2) = o;
                    if (LP_SPLIT(KIND)) *(LAS v2u*)(F.lds + LP_LO + ti * LP_RS + (j * 256 + lane * 4) * 2) = q;
                }
                ssq4[tk] = ss;
            }
            {
                const float tot = wave_sum4(ssq4[0], ssq4[1], ssq4[2], ssq4[3], lane);
                const float r = rsqrtf(tot / (float)D + EPS);
                if ((lane & 15) == 0) { const int ti = 4 * w + (lane >> 4); rout[tbase + half * 32 + ti] = r; rls[ti] = r; }
            }
            if (PREF && half == 0) { __builtin_amdgcn_sched_barrier(0); loadx(1); __builtin_amdgcn_sched_barrier(0); }
        }
        LP_BAR();
        f32x4 acc[2][NT];
#pragma unroll
        for (int mt = 0; mt < 2; ++mt)
#pragma unroll
            for (int nt = 0; nt < NT; ++nt) acc[mt][nt] = (f32x4){0.f, 0.f, 0.f, 0.f};
        {
            const LAS unsigned char* ah = F.lds + fr * LP_RS + (w * 128 + fk * 8) * 2;
#pragma unroll
            for (int u = 0; u < 4; ++u)
#pragma unroll
                for (int mt = 0; mt < 2; ++mt) {
                    const pg8::bf16x8 aH = *(const LAS pg8::bf16x8*)(ah + mt * 16 * LP_RS + u * 64), aL = LP_SPLIT(KIND) ? *(const LAS pg8::bf16x8*)(ah + LP_LO + mt * 16 * LP_RS + u * 64) : aH;
#pragma unroll
                    for (int nt = 0; nt < NT; ++nt) {
                        acc[mt][nt] = __builtin_amdgcn_mfma_f32_16x16x32_bf16(aH, bH[u][nt], acc[mt][nt], 0, 0, 0);
                        if (LP_SPLIT(KIND)) acc[mt][nt] = __builtin_amdgcn_mfma_f32_16x16x32_bf16(aL, bH[u][nt], acc[mt][nt], 0, 0, 0);
                        if (LP_SPLIT(KIND)) acc[mt][nt] = __builtin_amdgcn_mfma_f32_16x16x32_bf16(aH, bL[u][nt], acc[mt][nt], 0, 0, 0);
                    }
                }
        }
        LP_BAR();
#pragma unroll
        for (int mt = 0; mt < 2; ++mt)
#pragma unroll
            for (int nt = 0; nt < NT; ++nt)
#pragma unroll
                for (int rg = 0; rg < 4; ++rg) part[(w * 32 + mt * 16 + 4 * fk + rg) * 48 + nt * 16 + fr] = acc[mt][nt][rg];
        LP_BAR();
        if (KIND == 3) {
            LAS float* lg = (LAS float*)(F.lds + 65536);
            const int g4 = lane >> 4, s16 = lane & 15, ti = 4 * w + g4, i = half * 32 + ti, t = tbase + i;
            auto sum8 = [&](int o) __attribute__((always_inline)) { return ((((part[(0 * 32 + ti) * 48 + o] + part[(1 * 32 + ti) * 48 + o]) + (part[(2 * 32 + ti) * 48 + o] + part[(3 * 32 + ti) * 48 + o]))
                                    + ((part[(4 * 32 + ti) * 48 + o] + part[(5 * 32 + ti) * 48 + o]) + (part[(6 * 32 + ti) * 48 + o] + part[(7 * 32 + ti) * 48 + o])))) * rls[ti]; };
            lg[ti * 48 + s16] = sum8(s16) + brs0; lg[ti * 48 + 16 + s16] = sum8(16 + s16) + brs1;
            if (s16 < 4) lg[ti * 48 + 32 + s16] = sum8(32 + s16) + brs2;
            asm volatile("s_waitcnt lgkmcnt(0)" ::: "memory");
            if (s16 == 0) {
                float gl[4];
#pragma unroll
                for (int o = 0; o < 4; ++o) gl[o] = lg[ti * 48 + 32 + o];
                int gi = 0; float gm = gl[0];
#pragma unroll
                for (int o = 1; o < 4; ++o) if (gl[o] > gm) { gm = gl[o]; gi = o; }
                float gs = 0.f;
#pragma unroll
                for (int o = 0; o < 4; ++o) gs += expf(gl[o] - gm);
                const float ggate = 1.0f / gs;
                float ein[8];
#pragma unroll
                for (int k = 0; k < 8; ++k) ein[k] = lg[ti * 48 + 8 * gi + k];
                int i1 = 0; float v1 = ein[0];
#pragma unroll
                for (int k = 1; k < 8; ++k) if (ein[k] > v1) { v1 = ein[k]; i1 = k; }
                int i2 = -1; float v2 = -INFINITY;
#pragma unroll
                for (int k = 0; k < 8; ++k) if (k != i1 && ein[k] > v2) { v2 = ein[k]; i2 = k; }
                if (i2 < 0) i2 = (i1 + 1) & 7;
                const float e2 = expf(v2 - v1);
                slot_w[t * 2 + 0] = ggate / (1.0f + e2); slot_w[t * 2 + 1] = ggate * e2 / (1.0f + e2);
                const int ea = gi * 8 + i1, eb = gi * 8 + i2;
                tokinfo[i * 4 + 0] = ea; tokinfo[i * 4 + 1] = eb;
                tokinfo[i * 4 + 2] = __hip_atomic_fetch_add(hist + ea, 1, __ATOMIC_RELAXED, __HIP_MEMORY_SCOPE_WORKGROUP); tokinfo[i * 4 + 3] = __hip_atomic_fetch_add(hist + eb, 1, __ATOMIC_RELAXED, __HIP_MEMORY_SCOPE_WORKGROUP);
            }
        } else if (LP_D16) {
            const int g4 = lane >> 4, s16 = lane & 15, ti = 4 * w + g4, i = half * 32 + ti, t = tbase + i;
            auto sum8 = [&](int o) __attribute__((always_inline)) { return ((((part[(0 * 32 + ti) * 48 + o] + part[(1 * 32 + ti) * 48 + o]) + (part[(2 * 32 + ti) * 48 + o] + part[(3 * 32 + ti) * 48 + o]))
                                    + ((part[(4 * 32 + ti) * 48 + o] + part[(5 * 32 + ti) * 48 + o]) + (part[(6 * 32 + ti) * 48 + o] + part[(7 * 32 + ti) * 48 + o])))) * rls[ti]; };
            const float a_ = sum8(s16), b_ = sum8(16 + s16);
            float2 c;
            if (KIND == 0) { const float inv = 1.0f / powf(10000.0f, (float)(2 * s16) / 32.0f); c = cossin_f((float)(t % S) * inv); }
            else c = cs32[(t % S) * 16 + s16];
            krope[(size_t)t * 32 + s16] = f2bf(a_ * c.x - b_ * c.y); krope[(size_t)t * 32 + 16 + s16] = f2bf(b_ * c.x + a_ * c.y);
        } else {
        float2 cq0 = make_float2(0.f, 0.f), cq1 = cq0, cq2 = cq0, cq3 = cq0;
        if (PREF && KIND != 3) { cq0 = csq[half][0]; cq1 = csq[half][1]; cq2 = csq[half][2]; cq3 = csq[half][3]; }
#pragma unroll 1
        for (int tk = 0; tk < 4; ++tk) {
            const int ti = 4 * w + tk, i = half * 32 + ti, t = tbase + i;
            float v = 0.f;
            if (lane < NT * 16) v = ((((part[(0 * 32 + ti) * 48 + lane] + part[(1 * 32 + ti) * 48 + lane]) + (part[(2 * 32 + ti) * 48 + lane] + part[(3 * 32 + ti) * 48 + lane]))
                                    + ((part[(4 * 32 + ti) * 48 + lane] + part[(5 * 32 + ti) * 48 + lane]) + (part[(6 * 32 + ti) * 48 + lane] + part[(7 * 32 + ti) * 48 + lane])))) * rls[ti];
            if (KIND != 3) {
                const float partner = __shfl_xor(v, 16);
                const int oo = lane & 31;
                float2 c = cq0; cq0 = cq1; cq1 = cq2; cq2 = cq3;
                if (!PREF) c = cs32[(t % S) * 16 + (oo & 15)];
                const float ro = (oo < 16) ? (v * c.x - partner * c.y) : (v * c.x + partner * c.y);
                if (lane < 32) krope[(size_t)t * 32 + oo] = f2bf(ro);
            } else {
                float gl[4];
#pragma unroll
                for (int o = 0; o < 4; ++o) gl[o] = __shfl(v, 32 + o) + brgv[o];
                int gi = 0; float gm = gl[0];
#pragma unroll
                for (int o = 1; o < 4; ++o) if (gl[o] > gm) { gm = gl[o]; gi = o; }
                float gs = 0.f;
#pragma unroll
                for (int o = 0; o < 4; ++o) gs += expf(gl[o] - gm);
                const float ggate = 1.0f / gs;
                const float evb = v + brev;
                float ein[8];
#pragma unroll
                for (int k = 0; k < 8; ++k) ein[k] = __shfl(evb, 8 * gi + k);
                int i1 = 0; float v1 = ein[0];
#pragma unroll
                for (int k = 1; k < 8; ++k) if (ein[k] > v1) { v1 = ein[k]; i1 = k; }
                int i2 = -1; float v2 = -INFINITY;
#pragma unroll
                for (int k = 0; k < 8; ++k) if (k != i1 && ein[k] > v2) { v2 = ein[k]; i2 = k; }
                if (i2 < 0) i2 = (i1 + 1) & 7;
                const float e2 = expf(v2 - v1);
                if (lane == 0) {
                    slot_w[t * 2 + 0] = ggate / (1.0f + e2); slot_w[t * 2 + 1] = ggate * e2 / (1.0f + e2);
                    const int ea = gi * 8 + i1, eb = gi * 8 + i2;
                    tokinfo[i * 4 + 0] = ea; tokinfo[i * 4 + 1] = eb;
                    tokinfo[i * 4 + 2] = __hip_atomic_fetch_add(hist + ea, 1, __ATOMIC_RELAXED, __HIP_MEMORY_SCOPE_WORKGROUP); tokinfo[i * 4 + 3] = __hip_atomic_fetch_add(hist + eb, 1, __ATOMIC_RELAXED, __HIP_MEMORY_SCOPE_WORKGROUP);
                }
            }
        }
        }
        LP_BAR();
    }
    if (KIND == 3) {
        if (tid < 32) { const int c = hist[tid]; hist[32 + tid] = c ? atomicAdd(cnt + tid, c) : 0; }
        __syncthreads();
        if (tid < 128) {
            const int i = tid >> 1, k = tid & 1, e = tokinfo[i * 4 + k], rank = tokinfo[i * 4 + 2 + k];
            list[(size_t)e * LCAP + hist[32 + e] + rank] = (tbase + i) * 2 + k;
        }
        __syncthreads();
    }
}

struct DenseOrder {
    int nM, nN, G, c; const pg8::bf16_t* Bt; int ldb;
    __device__ __forceinline__ bool next(int i, pg8::Unit& u) const {
        const int L = i * G + c; if (L >= nM * nN) return false;
        u.pm = L / nN; u.pn = L % nN; u.e = 0; u.cnt = 256; u.tau = 0; return true;
    }
    __device__ __forceinline__ unsigned arow(const pg8::Unit& u, int r) const { return (unsigned)(u.pm * 256 + r); }
    __device__ __forceinline__ const pg8::bf16_t* bbase(const pg8::Unit& u) const { return Bt + (size_t)u.pn * 256 * ldb; }
};

template <bool WT = false>
__device__ __forceinline__ void st_pair16(bf16* grp, int fq, v2u w0, v2u w1) {
    const auto rx = __builtin_amdgcn_permlane16_swap(w0.x, w1.x, false, false);
    const auto ry = __builtin_amdgcn_permlane16_swap(w0.y, w1.y, false, false);
    v4u w; w.x = rx[0]; w.y = ry[0]; w.z = rx[1]; w.w = ry[1];
    bf16* p = grp + ((fq & 1) ? 16 + 4 * (fq - 1) : 4 * fq);
    if (WT) asm volatile("global_store_dwordx4 %0, %1, off sc1\n\ts_nop 1" :: "v"(p), "v"(w) : "memory");
    else *(v4u*)p = w;
}
struct EpiU {
    static constexpr bool PERM = false;
    bf16* O; const float* rs; float* ssq; const float2* cs32; const float2* cs64;
    __device__ __forceinline__ void operator()(const pg8::f32x4 (&acc)[2][2][4][2], const pg8::Unit& u, int wr, int wc, int fr, int fq) const {
        const int row0 = u.pm * 256 + wr * 64 + fr;
        float scv[2][4];
#pragma unroll
        for (int ai = 0; ai < 2; ++ai)
#pragma unroll
            for (int m = 0; m < 4; ++m) scv[ai][m] = rs[row0 + ai * 128 + m * 16];
#pragma unroll
        for (int bj = 0; bj < 2; ++bj) {
            const int G32 = u.pn * 8 + bj * 4 + wc, col0 = G32 * 32 + 4 * fq;
            int kind; float qs = 1.f;
            if (G32 < 12) kind = 0; else if (G32 < 20) kind = 1; else if (G32 < 32) { kind = 2; qs = 0.125f * LOG2E; } else if (G32 < 36) kind = 3;
            else if (G32 < 40) kind = 4; else if (G32 < 48) { kind = 5; qs = 0.17677669529663687f * LOG2E; } else if (G32 < 56) kind = 6; else kind = 4;
            const bool rope = (kind > 1) && (kind != 4);
#pragma unroll
            for (int ai = 0; ai < 2; ++ai) {
                pg8::f32x4 ca[4][2];
                if (rope) {
#pragma unroll
                    for (int m = 0; m < 4; ++m) {
                        const int spos = (row0 + ai * 128 + m * 16) % S;
                        const float2* cs = (kind == 2 || kind == 3) ? cs64 + spos * 32 + 16 * (G32 & 1) + 4 * fq : cs32 + spos * 16 + 4 * fq;
                        ca[m][0] = *(const pg8::f32x4*)cs; ca[m][1] = *(const pg8::f32x4*)(cs + 2);
                    }
                    __builtin_amdgcn_sched_barrier(0);
                }
#pragma unroll
                for (int m = 0; m < 4; ++m) {
                    const int row = row0 + ai * 128 + m * 16; const float sc = scv[ai][m];
                    pg8::f32x4 v0 = acc[ai][bj][m][0] * sc, v1 = acc[ai][bj][m][1] * sc;
                    if (kind <= 1) {
                        float s = v0[0] * v0[0] + v0[1] * v0[1] + v0[2] * v0[2] + v0[3] * v0[3] + v1[0] * v1[0] + v1[1] * v1[1] + v1[2] * v1[2] + v1[3] * v1[3];
                        s += __shfl_xor(s, 16); s += __shfl_xor(s, 32);
                        if (fq == 0) ssq[(size_t)row * 20 + G32] = s;
                    } else if (rope) {
#pragma unroll
                        for (int j = 0; j < 4; ++j) { const float cx = ca[m][j >> 1][2 * (j & 1)], cy = ca[m][j >> 1][2 * (j & 1) + 1]; const float x1 = v0[j], x2 = v1[j]; v0[j] = (x1 * cx - x2 * cy) * qs; v1[j] = (x2 * cx + x1 * cy) * qs; }
                    }
                    v2u w0, w1; w0.x = pk2(v0[0], v0[1]); w0.y = pk2(v0[2], v0[3]); w1.x = pk2(v1[0], v1[1]); w1.y = pk2(v1[2], v1[3]);
                    st_pair16(O + (size_t)row * 2048 + G32 * 32, fq, w0, w1);
                }
                asm volatile("" ::: "memory");
            }
        }
    }
};
__device__ __forceinline__ void p1_gemm(const Frame& F, AP a, int l) {
    pg8::Gemm g{(const pg8::bf16_t*)(a->ws + WS_XA), (const pg8::bf16_t*)(a->ws + WS_WSMALL + (size_t)l * WSM_LAYER + WSM_IN), 1024, 1024, 1024};
    DenseOrder S_{T / 256, 2048 / 256, F.G, F.vcu, g.Bt, 1024};
    EpiU E{(bf16*)(a->ws + WS_U), (const float*)(a->ws + WS_RA), (float*)(a->ws + WS_SSQP), (const float2*)(a->ws + WS_CS32), (const float2*)(a->ws + WS_CS64)};
    pg8::gemm_phase<EpiU, DenseOrder, true>(F.lds, g, S_, E, F.wave, F_LANE);
}

struct EpiQ {
    static constexpr bool PERM = false;
    bf16* O; const float* ssq; const float2* cs32;
    __device__ __forceinline__ void operator()(const pg8::f32x4 (&acc)[2][2][4][2], const pg8::Unit& u, int wr, int wc, int fr, int fq) const {
        const int row0 = u.pm * 256 + wr * 64 + fr; const float qs = 0.10206207261596577f * LOG2E;
        float scv[2][4];
#pragma unroll
        for (int ai = 0; ai < 2; ++ai) {
            pg8::f32x4 sa[4], sb[4], sc3[4];
#pragma unroll
            for (int m = 0; m < 4; ++m) { const float* sp = ssq + (size_t)(row0 + ai * 128 + m * 16) * 20; sa[m] = *(const pg8::f32x4*)sp; sb[m] = *(const pg8::f32x4*)(sp + 4); sc3[m] = *(const pg8::f32x4*)(sp + 8); }
            __builtin_amdgcn_sched_barrier(0);
#pragma unroll
            for (int m = 0; m < 4; ++m) {
                const float sq = ((sa[m][0] + sa[m][1]) + (sa[m][2] + sa[m][3])) + ((sb[m][0] + sb[m][1]) + (sb[m][2] + sb[m][3])) + ((sc3[m][0] + sc3[m][1]) + (sc3[m][2] + sc3[m][3]));
                scv[ai][m] = rsqrtf(sq * (1.0f / 384.0f) + EPS) * qs;
            }
        }
#pragma unroll
        for (int bj = 0; bj < 2; ++bj) {
            const int G32 = u.pn * 8 + bj * 4 + wc, col0 = G32 * 32 + 4 * fq;
            if (G32 >= 18) continue;
            const bool rope = (G32 % 3) == 2;
#pragma unroll
            for (int ai = 0; ai < 2; ++ai) {
                pg8::f32x4 ca[4][2];
                if (rope) {
#pragma unroll
                    for (int m = 0; m < 4; ++m) { const float2* cs = cs32 + ((row0 + ai * 128 + m * 16) % S) * 16 + 4 * fq; ca[m][0] = *(const pg8::f32x4*)cs; ca[m][1] = *(const pg8::f32x4*)(cs + 2); }
                    __builtin_amdgcn_sched_barrier(0);
                }
#pragma unroll
                for (int m = 0; m < 4; ++m) {
                    const int row = row0 + ai * 128 + m * 16; const float sc = scv[ai][m];
                    pg8::f32x4 v0 = acc[ai][bj][m][0] * sc, v1 = acc[ai][bj][m][1] * sc;
                    if (rope) {
#pragma unroll
                        for (int j = 0; j < 4; ++j) { const float cx = ca[m][j >> 1][2 * (j & 1)], cy = ca[m][j >> 1][2 * (j & 1) + 1]; const float x1 = v0[j], x2 = v1[j]; v0[j] = x1 * cx - x2 * cy; v1[j] = x2 * cx + x1 * cy; } }
                    v2u w0, w1; w0.x = pk2(v0[0], v0[1]); w0.y = pk2(v0[2], v0[3]); w1.x = pk2(v1[0], v1[1]); w1.y = pk2(v1[2], v1[3]);
                    st_pair16<true>(O + (size_t)row * 576 + G32 * 32, fq, w0, w1);
                }
                asm volatile("" ::: "memory");
            }
        }
    }
};
struct EpiKV {
    static constexpr bool PERM = true;
    bf16* O; const float* ssq;
    __device__ __forceinline__ void operator()(const pg8::f32x4 (&acc)[2][2][4][2], const pg8::Unit& u, int wr, int wc, int fr, int fq) const {
        const int row0 = u.pm * 256 + wr * 64 + fr, col0 = u.pn * 256 + wc * 32 + 8 * fq;
        float scv[2][4];
        {
            pg8::f32x4 sa[2][4], sb[2][4];
#pragma unroll
            for (int ai = 0; ai < 2; ++ai)
#pragma unroll
                for (int m = 0; m < 4; ++m) { const float* sp = ssq + (size_t)(row0 + ai * 128 + m * 16) * 20 + 12; sa[ai][m] = *(const pg8::f32x4*)sp; sb[ai][m] = *(const pg8::f32x4*)(sp + 4); }
            __builtin_amdgcn_sched_barrier(0);
#pragma unroll
            for (int ai = 0; ai < 2; ++ai)
#pragma unroll
                for (int m = 0; m < 4; ++m) scv[ai][m] = rsqrtf((((sa[ai][m][0] + sa[ai][m][1]) + (sa[ai][m][2] + sa[ai][m][3])) + ((sb[ai][m][0] + sb[ai][m][1]) + (sb[ai][m][2] + sb[ai][m][3]))) * (1.0f / 256.0f) + EPS);
        }
#pragma unroll
        for (int ai = 0; ai < 2; ++ai)
#pragma unroll
            for (int m = 0; m < 4; ++m) {
                const int row = row0 + ai * 128 + m * 16; const float sc = scv[ai][m];
                bf16* rowp = O + (size_t)row * 768 + col0;
#pragma unroll
                for (int bj = 0; bj < 2; ++bj) { const pg8::f32x4 v0 = acc[ai][bj][m][0] * sc, v1 = acc[ai][bj][m][1] * sc;
                    v4u w; w.x = pk2(v0[0], v0[1]); w.y = pk2(v0[2], v0[3]); w.z = pk2(v1[0], v1[1]); w.w = pk2(v1[2], v1[3]);
                    asm volatile("global_store_dwordx4 %0, %1, off sc1\n\ts_nop 1" :: "v"(rowp + bj * 128), "v"(w) : "memory"); }
            }
        asm volatile("" ::: "memory");
    }
};
__device__ __forceinline__ void p1b_q(const Frame& F, AP a, int l) {
    const float* ssq = (const float*)(a->ws + WS_SSQP);
    unsigned char* wl = a->ws + WS_WSMALL + (size_t)l * WSM_LAYER;
    pg8::Gemm g{(const pg8::bf16_t*)(a->ws + WS_U), (const pg8::bf16_t*)(wl + WSM_UQ), 2048, 384, 384};
    DenseOrder S_{T / 256, 3, F.G, F.vcu, g.Bt, 384};
    EpiQ E{(bf16*)(a->ws + WS_QM), ssq, (const float2*)(a->ws + WS_CS32)};
    pg8::gemm_phase<EpiQ, DenseOrder, true>(F.lds, g, S_, E, F.wave, F_LANE);
}
__device__ __forceinline__ void p1b_kv(const Frame& F, AP a, int l) {
    const float* ssq = (const float*)(a->ws + WS_SSQP);
    unsigned char* wl = a->ws + WS_WSMALL + (size_t)l * WSM_LAYER;
    pg8::Gemm g{(const pg8::bf16_t*)(a->ws + WS_U) + 384, (const pg8::bf16_t*)(wl + WSM_UKV), 2048, 256, 256};
    DenseOrder S_{T / 256, 3, F.G, (F.vcu + 64) % F.G, g.Bt, 256};
    EpiKV E{(bf16*)(a->ws + WS_KVM), ssq};
    pg8::gemm_phase<EpiKV, DenseOrder, true>(F.lds, g, S_, E, F.wave, F_LANE);
    asm volatile("s_waitcnt vmcnt(0)" ::: "memory");
    __syncthreads();
    if (F.wave == 0 && F_LANE == 0)
        __hip_atomic_fetch_add((unsigned*)(a->ws + WS_CTL + CTL_ATTQ) + l * 256 + 192, 1u, __ATOMIC_RELAXED, __HIP_MEMORY_SCOPE_AGENT);
}

__device__ __forceinline__ void attn_phase(const Frame& F, AP a, int l) {
    const bf16* U = (const bf16*)(a->ws + WS_U); bf16* Oc = (bf16*)(a->ws + WS_XB);
    const float lambda_init = __uint_as_float((l == 0) ? 0x3e4ccccdu : 0x3eb60549u);
    const float omli_ = __uint_as_float((l == 0) ? 0x3f4ccccdu : 0x3f24fd5cu);
    float d1 = 0.f, d2 = 0.f;
    for (int i = 0; i < 32; ++i) { d1 += a->in[8][l * 32 + i] * a->in[9][l * 32 + i]; d2 += a->in[10][l * 32 + i] * a->in[11][l * 32 + i]; }
    const float lam = expf(d1) - expf(d2) + lambda_init;
    const int nd = NB * 32, nm = NB * 48, nsw = NB * 48;
    const int lane = F_LANE;
    unsigned* ctr = (unsigned*)(a->ws + WS_CTL + CTL_ATTQ) + l * 256;
    volatile LAS unsigned* slot = (volatile LAS unsigned*)(F.lds + LDS_MISC);
#define ATT_NEXT(q, u) do { if (F.wave == 0 && lane == 0) slot[0] = __hip_atomic_fetch_add(ctr + 64 * (q), 1u, __ATOMIC_RELAXED, __HIP_MEMORY_SCOPE_AGENT); \
        __syncthreads(); u = (int)slot[0]; __syncthreads(); } while (0)
    if ((F.vcu % CONV_MOD) == 0) {
#pragma unroll 1
        for (;;) { int u; if (F.wave == 0 && lane == 0) slot[0] = __hip_atomic_fetch_add(ctr + 32, 1u, __ATOMIC_RELAXED, __HIP_MEMORY_SCOPE_AGENT);
            __syncthreads(); u = (int)slot[0]; __syncthreads(); if (u >= CONV_CHUNKS + (l == 0 ? P0_REST_CHUNKS : 0)) break;
            if (u < CONV_CHUNKS) conv_chunk(F, a, l, u); else p0_rest_chunk(F, a, u - CONV_CHUNKS); }
    }
    {
        const att::AttnP pd{U, 2048, 1280, 64, U, 2048, 1536, 64, 1, nullptr, 0, U, 2048, 1792, 64, 1, Oc, D, 768, 64, nullptr, lam, omli_, a->in[12] + l * 64, seam_ctr(a->ws, l, 1, 0)};
#pragma unroll 1
        for (;;) { int u; ATT_NEXT(0, u); if (u >= nd) break; att::attn_unit<2>(pd, u / 32, (u % 32) / 8, u % 8, (att::ldsp)F.lds, F.wave, lane); }
    }
    {
        if (F.wave == 0 && lane == 0) {
            unsigned sp = 0;
            while (__hip_atomic_load(ctr + 192, __ATOMIC_RELAXED, __HIP_MEMORY_SCOPE_AGENT) < (unsigned)F.G) { __builtin_amdgcn_s_sleep(2); if (++sp > (1u << 24)) break; }
            __builtin_amdgcn_fence(__ATOMIC_ACQUIRE, "agent");
            asm volatile("s_waitcnt vmcnt(0)" ::: "memory");
        }
        __syncthreads();
    }
    {
        const att::AttnP pm{(const bf16*)(a->ws + WS_QM), 576, 0, 96, (const bf16*)(a->ws + WS_KVM), 768, 0, 128, 1, (const bf16*)(a->ws + WS_KROPE), 32, (const bf16*)(a->ws + WS_KVM), 768, 64, 128, 1, Oc, D, 0, 64, nullptr, 0.f, 0.f, nullptr, seam_ctr(a->ws, l, 1, 0)};
#pragma unroll 1
        for (;;) { int u; ATT_NEXT(1, u); if (u >= nm) break; att::attn_unit<0>(pm, u / 48, (u % 48) / 8, u % 8, (att::ldsp)F.lds, F.wave, lane); }
    }
    {
        const att::AttnP ps{U, 2048, 640, 64, U, 2048, 1024, 64, 3, nullptr, 0, U, 2048, 1152, 64, 3, Oc, D, 384, 64, a->in[7] + l * 6, 0.f, 0.f, nullptr, seam_ctr(a->ws, l, 1, 0)};
#pragma unroll 1
        for (;;) { int u; ATT_NEXT(2, u); if (u >= nsw) break; att::attn_unit<1>(ps, u / 48, (u % 48) / 8, u % 8, (att::ldsp)F.lds, F.wave, lane); }
    }
#undef ATT_NEXT
}

#ifndef EPIRES_ROWS
#define EPIRES_ROWS 2
#endif
template <bool RESB>
struct EpiRes {
    static constexpr bool PERM = false;
    const float* res; const bf16* resb; bf16* O;
    __device__ __forceinline__ void operator()(const pg8::f32x4 (&acc)[2][2][4][2], const pg8::Unit& u, int wr, int wc, int fr, int fq) const {
        const int row0 = u.pm * 256 + wr * 64 + fr, col0 = u.pn * 256 + wc * 32 + 4 * fq;
#pragma unroll
        for (int ai = 0; ai < 2; ++ai)
#pragma unroll
            for (int mp = 0; mp < 4; mp += EPIRES_ROWS) {
                pg8::f32x4 r[RESB ? 1 : EPIRES_ROWS][2][2]; v2u rb[RESB ? EPIRES_ROWS : 1][2][2];
#pragma unroll
                for (int m = 0; m < EPIRES_ROWS; ++m)
#pragma unroll
                    for (int bj = 0; bj < 2; ++bj)
#pragma unroll
                        for (int n = 0; n < 2; ++n) {
                            const size_t off = (size_t)(row0 + ai * 128 + (mp + m) * 16) * D + col0 + bj * 128 + n * 16;
                            if (RESB) rb[RESB ? m : 0][bj][n] = *(const v2u*)(resb + off); else r[RESB ? 0 : m][bj][n] = *(const pg8::f32x4*)(res + off);
                        }
                __builtin_amdgcn_sched_barrier(0);
#pragma unroll
                for (int m = 0; m < EPIRES_ROWS; ++m)
#pragma unroll
                    for (int bj = 0; bj < 2; ++bj) {
                        v2u w[2];
#pragma unroll
                        for (int n = 0; n < 2; ++n) {
                            pg8::f32x4 x;
                            if (RESB) { const v2u q = rb[RESB ? m : 0][bj][n]; x = (pg8::f32x4){__uint_as_float(q.x << 16), __uint_as_float(q.x & 0xffff0000u), __uint_as_float(q.y << 16), __uint_as_float(q.y & 0xffff0000u)}; }
                            else x = r[RESB ? 0 : m][bj][n];
                            x = x + acc[ai][bj][mp + m][n];
                            w[n].x = pk2(x[0], x[1]); w[n].y = pk2(x[2], x[3]);
                        }
                        st_pair16<true>(O + (size_t)(row0 + ai * 128 + (mp + m) * 16) * D + u.pn * 256 + bj * 128 + wc * 32, fq, w[0], w[1]);
                    }
                asm volatile("" ::: "memory");
            }
    }
};
__device__ __forceinline__ void p3_outproj(const Frame& F, AP a, int l) {
    pg8::Gemm g{(const pg8::bf16_t*)(a->ws + WS_XB), (const pg8::bf16_t*)(a->ws + WS_WSMALL + (size_t)l * WSM_LAYER + WSM_OUT), 1024, 1024, 1024};
    DenseOrder S_{T / 256, 4, F.G, F.vcu, g.Bt, 1024};
    seam_wait(F, seam_ctr(a->ws, l, 1, F.vcu / 4), 128u);
    { EpiRes<true> E{nullptr, (const bf16*)(a->ws + WS_XA), (bf16*)(a->ws + WS_XA)}; pg8::gemm_phase<EpiRes<true>, DenseOrder, true>(F.lds, g, S_, E, F.wave, F_LANE); }
    asm volatile("s_waitcnt vmcnt(0)" ::: "memory"); __syncthreads();
    if (F.wave == 0 && F_LANE == 0) __hip_atomic_fetch_add(seam_ctr(a->ws, l, 0, F.vcu / 4), 1u, __ATOMIC_RELAXED, __HIP_MEMORY_SCOPE_AGENT);
}

struct MoeOrder {
    int nN, G, c; const LAS int* tstart; const int* cnt; const int* list; const pg8::bf16_t* Bt; int ldb; size_t estride; int shift;
    __device__ __forceinline__ bool next(int i, pg8::Unit& u) const {
        const int L = i * G + c, tau = L / nN; if (tau >= tstart[32]) return false;
        int e = 0;
#pragma unroll 1
        for (int k = 16; k >= 1; k >>= 1) if (tstart[e + k] <= tau) e += k;
        u.e = e; u.pm = tau - tstart[e]; u.pn = L % nN; u.cnt = cnt[e] - u.pm * 256; u.tau = tau; return true;
    }
    __device__ __forceinline__ unsigned arow(const pg8::Unit& u, int r) const { const int rr = r < u.cnt ? r : 0; return (unsigned)(list[(size_t)u.e * LCAP + u.pm * 256 + rr] >> shift); }
    __device__ __forceinline__ const pg8::bf16_t* bbase(const pg8::Unit& u) const { return Bt + (size_t)u.e * estride + (size_t)u.pn * 256 * ldb; }
};
struct MoeQueue {
    int nN; const LAS int* tstart; const int* cnt; const int* list; const pg8::bf16_t* Bt; int ldb; size_t estride;
    unsigned* ctr; unsigned* tdone; volatile LAS int* slot; int wave, lane;
    __device__ __forceinline__ bool next(int i, pg8::Unit& u) const {
        if (wave == 0 && lane == 0) {
            const int L = (int)__hip_atomic_fetch_add(ctr, 1u, __ATOMIC_RELAXED, __HIP_MEMORY_SCOPE_AGENT);
            const int tau = L / nN;
            if (tau < tstart[32]) {
                unsigned sp = 0;
                while (__hip_atomic_load(tdone + tau, __ATOMIC_RELAXED, __HIP_MEMORY_SCOPE_AGENT) < 16u) { __builtin_amdgcn_s_sleep(2); if (++sp > (1u << 24)) break; }
                __builtin_amdgcn_fence(__ATOMIC_ACQUIRE, "agent");
                asm volatile("s_waitcnt vmcnt(0)" ::: "memory");
            }
            slot[i & 1] = L;
        }
        asm volatile("s_waitcnt lgkmcnt(0)\n\ts_barrier" ::: "memory");
        const int L = slot[i & 1], tau = L / nN; if (tau >= tstart[32]) return false;
        int e = 0;
#pragma unroll 1
        for (int k = 16; k >= 1; k >>= 1) if (tstart[e + k] <= tau) e += k;
        u.e = e; u.pm = tau - tstart[e]; u.pn = L % nN; u.cnt = cnt[e] - u.pm * 256; u.tau = tau; return true;
    }
    __device__ __forceinline__ unsigned arow(const pg8::Unit& u, int r) const { const int rr = r < u.cnt ? r : 0; return (unsigned)list[(size_t)u.e * LCAP + u.pm * 256 + rr]; }
    __device__ __forceinline__ const pg8::bf16_t* bbase(const pg8::Unit& u) const { return Bt + (size_t)u.e * estride + (size_t)u.pn * 256 * ldb; }
};
struct EpiGU {
    static constexpr bool PERM = false;
    bf16* hid; const float* rF; const float* slot_w; const int* list; unsigned* tdone;
    __device__ __forceinline__ void operator()(const pg8::f32x4 (&acc)[2][2][4][2], const pg8::Unit& u, int wr, int wc, int fr, int fq) const {
        const int* lp = list + (size_t)u.e * LCAP + u.pm * 256;
        int slot[2][4]; float rfv[2][4], wv[2][4];
#pragma unroll
        for (int ai = 0; ai < 2; ++ai)
#pragma unroll
            for (int m = 0; m < 4; ++m) { const int r = ai * 128 + wr * 64 + m * 16 + fr; slot[ai][m] = lp[r < u.cnt ? r : 0]; }
#pragma unroll
        for (int ai = 0; ai < 2; ++ai)
#pragma unroll
            for (int m = 0; m < 4; ++m) { rfv[ai][m] = rF[slot[ai][m] >> 1]; wv[ai][m] = slot_w[slot[ai][m]]; }
        __builtin_amdgcn_sched_barrier(0);
#pragma unroll
        for (int ai = 0; ai < 2; ++ai)
#pragma unroll
            for (int m = 0; m < 4; ++m) {
                const int r = ai * 128 + wr * 64 + m * 16 + fr;
                if (r < u.cnt) {
                    const float rf = rfv[ai][m], w = wv[ai][m];
                    bf16* rowp = hid + (size_t)slot[ai][m] * 256 + u.pn * 128 + wc * 16 + 4 * fq;
#pragma unroll
                    for (int bj = 0; bj < 2; ++bj) {
                        float h[4];
#pragma unroll
                        for (int j = 0; j < 4; ++j) { const float av = acc[ai][bj][m][0][j] * rf, uv = acc[ai][bj][m][1][j] * rf; h[j] = av * __builtin_amdgcn_rcpf(1.0f + __expf(-av)) * uv * w; }
                        const unsigned long long o = (unsigned long long)pk2(h[0], h[1]) | ((unsigned long long)pk2(h[2], h[3]) << 32);
                        __hip_atomic_store((unsigned long long*)(rowp + bj * 64), o, __ATOMIC_RELAXED, __HIP_MEMORY_SCOPE_AGENT);
                    }
                }
            }
        asm volatile("s_waitcnt vmcnt(0)" ::: "memory");
        if (fr == 0 && fq == 0) __hip_atomic_fetch_add(tdone + u.tau, 1u, __ATOMIC_RELAXED, __HIP_MEMORY_SCOPE_AGENT);
    }
};
#ifndef EPIDOWN_ROWS
#define EPIDOWN_ROWS 4
#endif
struct EpiDown {
    static constexpr bool PERM = true;
    bf16* y; const int* list;
    __device__ __forceinline__ void operator()(const pg8::f32x4 (&acc)[2][2][4][2], const pg8::Unit& u, int wr, int wc, int fr, int fq) const {
        const int* lp = list + (size_t)u.e * LCAP + u.pm * 256 + wr * 64 + fr; const int col0 = u.pn * 256 + wc * 32 + 8 * fq; const int cnt = u.cnt - (wr * 64 + fr);
#pragma unroll
        for (int ai = 0; ai < 2; ++ai)
#pragma unroll
            for (int mp = 0; mp < 4; mp += EPIDOWN_ROWS) {
                int slot[EPIDOWN_ROWS];
#pragma unroll
                for (int m = 0; m < EPIDOWN_ROWS; ++m) { const int r = ai * 128 + (mp + m) * 16; slot[m] = (r < cnt) ? lp[r] : 0; }
                __builtin_amdgcn_sched_barrier(0);
#pragma unroll
                for (int m = 0; m < EPIDOWN_ROWS; ++m) {
                    const int r = ai * 128 + (mp + m) * 16;
                    if (r < cnt) {
                        bf16* rowp = y + (size_t)slot[m] * D + col0;
#pragma unroll
                        for (int bj = 0; bj < 2; ++bj) { const pg8::f32x4 v0 = acc[ai][bj][mp + m][0], v1 = acc[ai][bj][mp + m][1];
                            v4u w; w.x = pk2(v0[0], v0[1]); w.y = pk2(v0[2], v0[3]); w.z = pk2(v1[0], v1[1]); w.w = pk2(v1[2], v1[3]);
                            asm volatile("global_store_dwordx4 %0, %1, off sc1\n\ts_nop 1" :: "v"(rowp + bj * 128), "v"(w) : "memory"); }
                    }
                }
                asm volatile("" ::: "memory");
            }
    }
};
__device__ __forceinline__ void moe_tiles(const Frame& F, const int* cnt) {
    LAS int* tstart = (LAS int*)(F.lds + LDS_MISC);
    if (F_TID == 0) { int acc = 0; for (int e = 0; e < 32; ++e) { tstart[e] = acc; acc += (cnt[e] + 255) >> 8; } tstart[32] = acc; }
    __syncthreads();
}
__device__ __forceinline__ void moe_gateup(const Frame& F, AP a, int l) {
    const int* cnt = (const int*)(a->ws + WS_CTL + CTL_CNT) + l * 32; const int* list = (const int*)(a->ws + WS_LIST);
    moe_tiles(F, cnt);
    pg8::Gemm g{(const pg8::bf16_t*)(a->ws + WS_XA), (const pg8::bf16_t*)(a->ws + WS_WGU), 1024, 1024, 1024};
    MoeOrder S_{2, F.G, F.vcu, (const LAS int*)(F.lds + LDS_MISC), cnt, list, g.Bt, 1024, (size_t)512 * 1024, 1};
    EpiGU E{(bf16*)(a->ws + WS_QM), (const float*)(a->ws + WS_RF), (const float*)(a->ws + WS_SLOTW), list, (unsigned*)(a->ws + WS_CTL + CTL_MOEQ) + l * 1024 + 64};
    pg8::gemm_phase<EpiGU, MoeOrder, true>(F.lds, g, S_, E, F.wave, F_LANE);
}
__device__ __forceinline__ void moe_down(const Frame& F, AP a, int l) {
    const int* cnt = (const int*)(a->ws + WS_CTL + CTL_CNT) + l * 32; const int* list = (const int*)(a->ws + WS_LIST);
    moe_tiles(F, cnt);
    pg8::Gemm g{(const pg8::bf16_t*)(a->ws + WS_QM), (const pg8::bf16_t*)(a->ws + WS_WD), 256, 256, 256};
    unsigned* q = (unsigned*)(a->ws + WS_CTL + CTL_MOEQ) + l * 1024;
    MoeQueue S_{4, (const LAS int*)(F.lds + LDS_MISC), cnt, list, g.Bt, 256, (size_t)1024 * 256, q, q + 64, (volatile LAS int*)(F.lds + LDS_MISC + 1024), F.wave, F_LANE};
    EpiDown E{(bf16*)(a->ws + WS_U), list};
    pg8::gemm_phase<EpiDown, MoeQueue, true>(F.lds, g, S_, E, F.wave, F_LANE);
}

__device__ __forceinline__ void run_phase(const Frame& F0, AP ap, int ph, int l, int rr = 0) {
    AP args = launder(ap);
    Frame F = F0;
    { int wv = F0.wave, vc = F0.vcu; asm volatile("" : "+s"(wv), "+s"(vc)); F.wave = wv; F.vcu = vc; }
    { int ln = lane_id(); asm volatile("" : "+v"(ln)); F.lane = ln; }
    switch (ph) {
        case 0: p0_small(F, args); break;
        case 1: p0_experts(F, args, l); break;
        case 2: light_pass<0>(F, args, l); break;
        case 3: p1_gemm(F, args, l); break;
        case 4: p1b_q(F, args, l); break;
        case 12: p1b_kv(F, args, l); break;
        case 5: attn_phase(F, args, l); break;
        case 6: p3_outproj(F, args, l); break;
        case 7: light_pass<3>(F, args, l, rr); break;
        case 8: moe_gateup(F, args, l); break;
        case 9: moe_down(F, args, l); break;
        case 10: light_pass<1>(F, args, l); break;
        case 11: norm_pass<2>(F, args, l); break;
        default: break;
    }
}
#ifndef USE_CG
#define USE_CG 0
#endif
typedef GAS unsigned gu32;
#define XB_TMO      128
#define XB_XCNT(j)  (256  + 64 * (j))
#define XB_XSUB(j)  (1280 + 64 * (j))
#define XB_XGEN(j)  (2304 + 64 * (j))
#define XB_TOP      3328
#define XB_TOPGEN   3392
#define XCD_BAR_WORDS 3456
#define XB_SPIN_CAP (1u << 22)
__device__ __forceinline__ unsigned xb_ld(unsigned* p)              { return __hip_atomic_load(p, __ATOMIC_RELAXED, __HIP_MEMORY_SCOPE_AGENT); }
__device__ __forceinline__ unsigned xb_add(unsigned* p, unsigned v) { return __hip_atomic_fetch_add(p, v, __ATOMIC_RELAXED, __HIP_MEMORY_SCOPE_AGENT); }
__device__ __forceinline__ unsigned xb_xcc_id() { return (unsigned)__builtin_amdgcn_s_getreg((3 << 11) | 20) & 0xFu; }
#define XB_SPIN(cond, bar) do { unsigned _sp = 0; while (cond) { __builtin_amdgcn_s_sleep(1); \
    if ((++_sp & 255u) == 0u) { if (xb_ld(&(bar)[XB_TMO])) break; if (_sp > XB_SPIN_CAP) { atomicAdd(&(bar)[XB_TMO], 1u); break; } } } } while (0)
struct XcdBarrier { unsigned* bar; unsigned x; volatile LAS unsigned* st; };
__device__ __forceinline__ XcdBarrier xcd_barrier_post(unsigned* bar, volatile LAS unsigned* st) {
    XcdBarrier b; b.bar = bar; b.x = xb_xcc_id(); b.st = st;
    if (threadIdx.x == 0) (void)xb_add(&bar[XB_XCNT(b.x)], 1u);
    return b;
}
__device__ __forceinline__ void xcd_barrier_complete(unsigned* bar, unsigned x, unsigned& nloc, unsigned& nx) {
    const unsigned G = gridDim.x * gridDim.y * gridDim.z;
    unsigned sum, cnt, mine, sp = 0u;
    for (;;) {
        sum = 0u; cnt = 0u; mine = 0u;
#pragma unroll
        for (unsigned j = 0; j < 16; ++j) { const unsigned c = xb_ld(&bar[XB_XCNT(j)]); sum += c; cnt += (c > 0u) ? 1u : 0u; mine = (j == x) ? c : mine; }
        if (sum == G) break;
        __builtin_amdgcn_s_sleep(1);
        if ((++sp & 255u) == 0u) { if (xb_ld(&bar[XB_TMO])) break; if (sp > XB_SPIN_CAP) { atomicAdd(&bar[XB_TMO], 1u); break; } }
    }
    nloc = mine > 0u ? mine : 1u; nx = cnt > 0u ? cnt : 1u;
}
__device__ __forceinline__ void xcd_barrier(const XcdBarrier& b, int wave) {
    asm volatile("s_waitcnt vmcnt(0)" ::: "memory");
    __syncthreads();
    int ln = lane_id(); asm volatile("" : "+v"(ln));
    if (wave == 0 && ln == 0) {
        unsigned* bar = b.bar;
        __builtin_amdgcn_s_waitcnt(0);
        unsigned nloc = b.st[0], nx = b.st[1];
        if (nloc == 0u) { xcd_barrier_complete(bar, b.x, nloc, nx); b.st[0] = nloc; b.st[1] = nx; }
        const unsigned old = xb_add(&bar[XB_XSUB(b.x)], 1u);
        const unsigned gen = old / nloc;
        if (old + 1u == (gen + 1u) * nloc) {
            __builtin_amdgcn_fence(__ATOMIC_RELEASE, "agent");
            asm volatile("s_waitcnt vmcnt(0)" ::: "memory");
            const unsigned og = xb_add(&bar[XB_TOP], 1u);
            const unsigned tg = og / nx;
            if (og + 1u == (tg + 1u) * nx) xb_add(&bar[XB_TOPGEN], 1u);
            else XB_SPIN(xb_ld(&bar[XB_TOPGEN]) == tg, bar);
            __builtin_amdgcn_fence(__ATOMIC_ACQUIRE, "agent");
            xb_add(&bar[XB_XGEN(b.x)], 1u);
            asm volatile("s_waitcnt vmcnt(0)" ::: "memory");
        } else {
            XB_SPIN(xb_ld(&bar[XB_XGEN(b.x)]) == gen, bar);
            __builtin_amdgcn_fence(__ATOMIC_ACQUIRE, "agent");
            asm volatile("s_waitcnt vmcnt(0)" ::: "memory");
        }
    }
    __syncthreads();
}
__device__ __forceinline__ void grid_sync(const XcdBarrier& b, int wave) {
#if USE_CG
    cooperative_groups::this_grid().sync();
#else
    xcd_barrier(b, wave);
#endif
}
constexpr unsigned long long LSEQ = 0x98765C43ull; constexpr int LSTEPS = 8; constexpr unsigned LBAR = 0xA1;
__global__ void __launch_bounds__(NWAVES * 64, 2) mega(Args args_unused) {
    extern __shared__ __attribute__((aligned(16))) unsigned char lds[];
    AP ap = (AP)__builtin_amdgcn_kernarg_segment_ptr();
    Frame F;
    F.lds = (LAS unsigned char*)lds;
    F.wave = __builtin_amdgcn_readfirstlane((int)threadIdx.x >> 6); F.lane = 0;
    F.G = gridDim.x; { const int bx = blockIdx.x; F.vcu = (F.G % 8 == 0) ? (bx % 8) * (F.G / 8) + bx / 8 : bx; }
    const int ph0 = ap->phase;
    volatile LAS unsigned* bst = (volatile LAS unsigned*)(lds + LDS_MISC + 8192);
    if (threadIdx.x < 2) bst[threadIdx.x] = 0u;
    __syncthreads();
    XcdBarrier xb; xb.bar = (unsigned*)(ap->ws + WS_CTL + CTL_BAR); xb.x = 0; xb.st = bst;
    if (ph0 < 0 && !USE_CG) xb = xcd_barrier_post((unsigned*)(ap->ws + WS_CTL + CTL_BAR), bst);
    const int npc = ph0 >= 0 ? 1 : 2 + NL * (LSTEPS + 1);
#pragma unroll 1
    for (int pc = 0; pc < npc; ++pc) {
        int ph, l, bar;
        if (ph0 >= 0) { ph = ph0; l = ap->layer; bar = 0; }
        else if (pc == 0) { ph = 0; l = 0; bar = 0; }
        else if (pc == 1) { ph = 2; l = 0; bar = 1; }
        else {
            const int q = pc - 2, s = q % (LSTEPS + 1); l = q / (LSTEPS + 1);
            if (s < LSTEPS) { ph = (int)((LSEQ >> (4 * s)) & 15ull); bar = (int)((LBAR >> s) & 1u); }
            else if (l + 1 < NL) { ph = 10; l = l + 1; bar = 1; }
            else { ph = 11; bar = 0; }
        }
        const int extra = ((ap->rep >> ph) & 1) && (l == 0 || !((ap->rep >> 29) & 1));
#pragma unroll 1
        for (int rr = 0; rr <= extra; ++rr) {
            run_phase(F, ap, ph, l, rr);
            if (rr < extra) grid_sync(xb, F.wave);
        }
        if (bar) { grid_sync(xb, F.wave); if ((ap->rep >> 30) & 1) { grid_sync(xb, F.wave); grid_sync(xb, F.wave); } } else __syncthreads();
    }
}
#ifndef REPMASK
#define REPMASK 0
#endif
extern "C" void kernel_launch(void* const* d_in, const int* in_sizes, int n_in, void* d_out, int out_size, void* d_ws, size_t ws_size, hipStream_t stream) {
    static int grid = 0;
    if (grid == 0) {
        int dev = 0, cus = 0, per_cu = 0;
        hipGetDevice(&dev); hipDeviceGetAttribute(&cus, hipDeviceAttributeMultiprocessorCount, dev);
        (void)hipFuncSetAttribute((const void*)mega, hipFuncAttributeMaxDynamicSharedMemorySize, LDS_BYTES);
        (void)hipOccupancyMaxActiveBlocksPerMultiprocessor(&per_cu, (const void*)mega, NWAVES * 64, LDS_BYTES);
        if (n_in != 23 || ws_size < WS_END || cus < 256 || per_cu < 1) { fprintf(stderr, "kernel_launch: unexpected configuration (n_in %d, ws %zu, CUs %d, blocks/CU %d)\n", n_in, ws_size, cus, per_cu); grid = -1; return; }
        grid = 256;
    }
    if (grid < 0) return;
    (void)hipMemsetAsync((char*)d_ws + WS_CTL, 0, CTL_BYTES, stream);
    Args a{};
    for (int i = 0; i < 23; ++i) a.in[i] = (const float*)d_in[i];
    a.out = (float*)d_out; a.ws = (unsigned char*)d_ws; a.phase = -1; a.layer = 0; a.rep = REPMASK;
    void* kargs[] = {&a};
    hipError_t e = hipLaunchCooperativeKernel((const void*)mega, dim3(grid), dim3(NWAVES * 64), kargs, LDS_BYTES, stream);
    if (e != hipSuccess) fprintf(stderr, "kernel_launch: cooperative launch failed: %s\n", hipGetErrorString(e));
}
```
